# Optimizing an MI355X kernel written in HIP

```python
import math
import jax, jax.numpy as jnp
from jax import lax
import numpy as np

D_MODEL = 1024
BATCH = 8
SEQ = 2048
DEPTH = 2

D_MIX = D_MODEL
GROUP_W = D_MIX // 4
MLA_HEADS = 4
MLA_NOPE = 64
MLA_ROPE = 32
MLA_V = GROUP_W // MLA_HEADS
MLA_Q_LORA = 192
MLA_KV_LORA = 128
ML_HEADS = 4
ML_DH = GROUP_W // ML_HEADS
ML_CHUNK = 64
SC_CH = GROUP_W
SC_WIDTH = 3
DF_HEADS = 4
DF_V = GROUP_W // DF_HEADS
DF_DK = DF_V // 2
Q_BLOCK = 128
ROPE_THETA = 10000.0
N_EXPERTS = 16
N_GROUPS = 4
E_PER_GROUP = N_EXPERTS // N_GROUPS
TOPK_GROUPS = 1
TOP_K = 2
D_EXPERT = 256
DN_ALPHA = (2 * DEPTH) ** 0.25
DN_BETA = (8 * DEPTH) ** -0.25
LN_EPS = 1e-5
RMS_EPS = 1e-6
IN_SIZES = (
    MLA_Q_LORA, MLA_KV_LORA, MLA_ROPE,
    GROUP_W, GROUP_W, GROUP_W, ML_HEADS, ML_HEADS, GROUP_W,
    SC_CH, SC_CH, SC_CH,
    2 * DF_HEADS * DF_DK, 2 * DF_HEADS * DF_DK, DF_HEADS * DF_V,
)
IN_COLS = sum(IN_SIZES)

kernel_name = "hybrid_mla_mlstm_conv_diffattn_grouped_moe"


def layer_norm(x):
    xf = x.astype(jnp.float32)
    mu = jnp.mean(xf, -1, keepdims=True)
    var = jnp.mean(jnp.square(xf - mu), -1, keepdims=True)
    return ((xf - mu) * lax.rsqrt(var + LN_EPS)).astype(x.dtype)


def rms_norm(x, g):
    xf = x.astype(jnp.float32)
    y = xf * lax.rsqrt(jnp.mean(xf * xf, -1, keepdims=True) + RMS_EPS)
    return y.astype(x.dtype) * g


def rope_tables(seq, dim):
    inv = 1.0 / (ROPE_THETA ** (jnp.arange(0, dim, 2, dtype=jnp.float32) / dim))
    ang = jnp.arange(seq, dtype=jnp.float32)[:, None] * inv[None, :]
    return jnp.cos(ang), jnp.sin(ang)


def apply_rope(x, cos, sin):
    x1, x2 = jnp.split(x, 2, axis=-1)
    cos = cos.astype(x.dtype)
    sin = sin.astype(x.dtype)
    return jnp.concatenate([x1 * cos - x2 * sin, x1 * sin + x2 * cos], axis=-1)


def split_cols(z):
    idx, acc = [], 0
    for sz in IN_SIZES[:-1]:
        acc += sz
        idx.append(acc)
    return jnp.split(z, idx, axis=-1)


def causal_block_attention(q, k, v, scale):
    b, g, s, dk = q.shape
    nb = s // Q_BLOCK
    qb = q.reshape(b, g, nb, Q_BLOCK, dk).transpose(2, 0, 1, 3, 4)
    key_pos = jnp.arange(s)

    def one_block(args):
        q_blk, start = args
        sc = jnp.einsum('bgqd,bgkd->bgqk', q_blk, k).astype(jnp.float32) * scale
        q_pos = start + jnp.arange(Q_BLOCK)
        sc = jnp.where(key_pos[None, :] <= q_pos[:, None], sc, -jnp.inf)
        p = jax.nn.softmax(sc, axis=-1).astype(v.dtype)
        return jnp.einsum('bgqk,bgkd->bgqd', p, v)

    out = lax.map(one_block, (qb, jnp.arange(nb) * Q_BLOCK))
    return out.transpose(1, 2, 0, 3, 4).reshape(b, g, s, v.shape[-1])


def mla_mixer(p_q, p_kv, k_rope, g_q, g_kv, w_uq, w_ukv, cos, sin):
    b, s, _ = p_q.shape
    q = (rms_norm(p_q, g_q) @ w_uq).reshape(b, s, MLA_HEADS, MLA_NOPE + MLA_ROPE).transpose(0, 2, 1, 3)
    kv = (rms_norm(p_kv, g_kv) @ w_ukv).reshape(b, s, MLA_HEADS, MLA_NOPE + MLA_V).transpose(0, 2, 1, 3)
    q_nope, q_pe = q[..., :MLA_NOPE], q[..., MLA_NOPE:]
    k_nope, v = kv[..., :MLA_NOPE], kv[..., MLA_NOPE:]
    q_pe = apply_rope(q_pe, cos, sin)
    k_pe = apply_rope(k_rope[:, None], cos, sin)
    qf = jnp.concatenate([q_nope, q_pe], -1)
    kf = jnp.concatenate([k_nope, jnp.broadcast_to(k_pe, k_nope.shape[:-1] + (MLA_ROPE,))], -1)
    o = causal_block_attention(qf, kf, v, (MLA_NOPE + MLA_ROPE) ** -0.5)
    return o.transpose(0, 2, 1, 3).reshape(b, s, MLA_HEADS * MLA_V)


def mlstm_mixer(q, k, v, i_pre, f_pre, o_pre):
    f32 = jnp.float32
    b, s, _ = q.shape
    L = ML_CHUNK
    nc = s // L

    def heads(t):
        return t.reshape(b, nc, L, ML_HEADS, ML_DH).transpose(0, 3, 1, 2, 4).astype(f32)

    def gates(t):
        return t.reshape(b, nc, L, ML_HEADS).transpose(0, 3, 1, 2).astype(f32)

    qh = heads(q) * (ML_DH ** -0.5)
    kh = heads(k)
    vh = heads(v)
    ig = gates(i_pre)
    lf = jax.nn.log_sigmoid(gates(f_pre))
    bcum = jnp.cumsum(lf, axis=-1)

    causal = jnp.tril(jnp.ones((L, L), dtype=bool))
    dmat = bcum[..., :, None] - bcum[..., None, :] + ig[..., None, :]
    dmat = jnp.where(causal, dmat, -jnp.inf)

    g_tot = bcum[..., -1]
    w_end = g_tot[..., None] - bcum + ig
    m_loc = jnp.max(w_end, axis=-1)
    a_end = jnp.exp(w_end - m_loc[..., None])
    c_loc = jnp.einsum('bhcl,bhcld,bhcle->bhcde', a_end, kh, vh)
    n_loc = jnp.einsum('bhcl,bhcld->bhcd', a_end, kh)

    def step(carry, inp):
        c_st, n_st, m_st = carry
        g, ml, cl, nl = inp
        m_new = jnp.maximum(g + m_st, ml)
        a = jnp.exp(g + m_st - m_new)
        bb = jnp.exp(ml - m_new)
        c_new = a[..., None, None] * c_st + bb[..., None, None] * cl
        n_new = a[..., None] * n_st + bb[..., None] * nl
        return (c_new, n_new, m_new), (c_st, n_st, m_st)

    init = (jnp.zeros((b, ML_HEADS, ML_DH, ML_DH), f32),
            jnp.zeros((b, ML_HEADS, ML_DH), f32),
            jnp.zeros((b, ML_HEADS), f32))
    xs = (jnp.moveaxis(g_tot, 2, 0), jnp.moveaxis(m_loc, 2, 0),
          jnp.moveaxis(c_loc, 2, 0), jnp.moveaxis(n_loc, 2, 0))
    _, (c_prev, n_prev, m_prev) = lax.scan(step, init, xs)
    c_prev = jnp.moveaxis(c_prev, 0, 2)
    n_prev = jnp.moveaxis(n_prev, 0, 2)
    m_prev = jnp.moveaxis(m_prev, 0, 2)

    inter_log = bcum + m_prev[..., None]
    m_j = jnp.maximum(inter_log, jnp.max(dmat, axis=-1))
    a_inter = jnp.exp(inter_log - m_j)
    a_intra = jnp.exp(dmat - m_j[..., None])
    s_qk = jnp.einsum('bhcjd,bhcsd->bhcjs', qh, kh) * a_intra
    num = (a_inter[..., None] * jnp.einsum('bhcjd,bhcde->bhcje', qh, c_prev)
           + jnp.einsum('bhcjs,bhcse->bhcje', s_qk, vh))
    den = a_inter * jnp.einsum('bhcjd,bhcd->bhcj', qh, n_prev) + jnp.sum(s_qk, axis=-1)
    h = num / jnp.maximum(jnp.abs(den), jnp.exp(-m_j))[..., None]
    h = h.transpose(0, 2, 3, 1, 4).reshape(b, s, ML_HEADS * ML_DH)
    return (jax.nn.sigmoid(o_pre.astype(f32)) * h).astype(q.dtype)


def short_conv_mixer(b_gate, c_gate, h, w_conv):
    u = c_gate * h
    y = lax.conv_general_dilated(u, w_conv[:, None, :], window_strides=(1,),
                                 padding=[(SC_WIDTH - 1, 0)],
                                 dimension_numbers=('NWC', 'WIO', 'NWC'),
                                 feature_group_count=SC_CH)
    return b_gate * y


def diff_attn_mixer(q, k, v, lq1, lk1, lq2, lk2, g_sub, lambda_init, cos, sin):
    b, s, _ = q.shape
    qh = q.reshape(b, s, 2 * DF_HEADS, DF_DK).transpose(0, 2, 1, 3)
    kh = k.reshape(b, s, 2 * DF_HEADS, DF_DK).transpose(0, 2, 1, 3)
    vh = v.reshape(b, s, DF_HEADS, DF_V).transpose(0, 2, 1, 3)
    qh = apply_rope(qh, cos, sin)
    kh = apply_rope(kh, cos, sin)
    v2 = jnp.repeat(vh, 2, axis=1)
    o = causal_block_attention(qh, kh, v2, DF_DK ** -0.5).reshape(b, DF_HEADS, 2, s, DF_V)
    lam = (jnp.exp(jnp.sum(lq1 * lk1).astype(jnp.float32))
           - jnp.exp(jnp.sum(lq2 * lk2).astype(jnp.float32)) + lambda_init)
    o = o[:, :, 0] - lam.astype(o.dtype) * o[:, :, 1]
    o = rms_norm(o, g_sub) * (1.0 - lambda_init)
    return o.transpose(0, 2, 1, 3).reshape(b, s, DF_HEADS * DF_V)


def grouped_moe(u, w_router, b_router, w1, w3, w2):
    b, s, d = u.shape
    t = u.reshape(b * s, d)
    scores = jax.nn.sigmoid((t @ w_router).astype(jnp.float32))
    sel = scores + b_router.astype(jnp.float32)
    grp_score = jnp.sum(lax.top_k(sel.reshape(-1, N_GROUPS, E_PER_GROUP), 2)[0], axis=-1)
    _, gidx = lax.top_k(grp_score, TOPK_GROUPS)
    gmask = jnp.any(gidx[..., None] == jnp.arange(N_GROUPS), axis=1)
    emask = jnp.repeat(gmask, E_PER_GROUP, axis=1)
    _, eidx = lax.top_k(jnp.where(emask, sel, -jnp.inf), TOP_K)
    w = jnp.take_along_axis(scores, eidx, axis=1)
    w = w / jnp.sum(w, axis=-1, keepdims=True)
    gates = jnp.sum(jax.nn.one_hot(eidx, N_EXPERTS, dtype=jnp.float32) * w[..., None], axis=1)
    h = jax.nn.silu(jnp.einsum('td,edf->tef', t, w1)) * jnp.einsum('td,edf->tef', t, w3)
    y = jnp.einsum('tef,efd->td', h * gates.astype(h.dtype)[..., None], w2)
    return y.reshape(b, s, d)


def setup_inputs(seed: int = 0) -> dict:
    key = jax.random.key(seed)
    ks = iter(jax.random.split(key, 32))
    f32 = jnp.float32
    L = DEPTH

    def nrm(shape, scale):
        return jax.random.normal(next(ks), shape, f32) * scale

    def gain(shape):
        return 1.0 + nrm(shape, 0.02)

    return {
        "x": nrm((BATCH, SEQ, D_MODEL), 1.0),
        "c": nrm((BATCH, D_MODEL), 1.0),
        "w_ada": nrm((L, D_MODEL, 6 * D_MODEL), 0.5 * D_MODEL ** -0.5),
        "b_ada": nrm((L, 6 * D_MODEL), 0.02),
        "w_in": nrm((L, D_MODEL, IN_COLS), D_MODEL ** -0.5),
        "mla_g_q": gain((L, MLA_Q_LORA)),
        "mla_g_kv": gain((L, MLA_KV_LORA)),
        "mla_w_uq": nrm((L, MLA_Q_LORA, MLA_HEADS * (MLA_NOPE + MLA_ROPE)), MLA_Q_LORA ** -0.5),
        "mla_w_ukv": nrm((L, MLA_KV_LORA, MLA_HEADS * (MLA_NOPE + MLA_V)), MLA_KV_LORA ** -0.5),
        "ml_b_i": nrm((L, ML_HEADS), 0.1),
        "ml_b_f": jnp.linspace(3.0, 6.0, ML_HEADS, dtype=f32)[None, :] + nrm((L, ML_HEADS), 0.1),
        "sc_w": nrm((L, SC_WIDTH, SC_CH), SC_WIDTH ** -0.5),
        "df_lq1": nrm((L, DF_DK), 0.1),
        "df_lk1": nrm((L, DF_DK), 0.1),
        "df_lq2": nrm((L, DF_DK), 0.1),
        "df_lk2": nrm((L, DF_DK), 0.1),
        "df_g": gain((L, DF_V)),
        "w_out": nrm((L, D_MIX, D_MODEL), DN_BETA * D_MIX ** -0.5),
        "ln1_g": gain((L, D_MODEL)),
        "ln1_b": nrm((L, D_MODEL), 0.02),
        "w_router": nrm((D_MODEL, N_EXPERTS), D_MODEL ** -0.5),
        "b_router": nrm((N_EXPERTS,), 0.01),
        "w1": nrm((L, N_EXPERTS, D_MODEL, D_EXPERT), D_MODEL ** -0.5),
        "w3": nrm((L, N_EXPERTS, D_MODEL, D_EXPERT), D_MODEL ** -0.5),
        "w2": nrm((L, N_EXPERTS, D_EXPERT, D_MODEL), DN_BETA * D_EXPERT ** -0.5),
        "ln2_g": gain((L, D_MODEL)),
        "ln2_b": nrm((L, D_MODEL), 0.02),
    }


def reference(x, c, w_ada, b_ada, w_in, mla_g_q, mla_g_kv, mla_w_uq, mla_w_ukv, ml_b_i, ml_b_f,
              sc_w, df_lq1, df_lk1, df_lq2, df_lk2, df_g, w_out, ln1_g, ln1_b,
              w_router, b_router, w1, w3, w2, ln2_g, ln2_b):
    s = x.shape[1]
    cos_a, sin_a = rope_tables(s, MLA_ROPE)
    cos_d, sin_d = rope_tables(s, DF_DK)
    c_act = jax.nn.silu(c)
    for l in range(DEPTH):
        mod = (c_act @ w_ada[l] + b_ada[l])[:, None, :]
        sh1, sc1, g1, sh2, sc2, g2 = jnp.split(mod, 6, axis=-1)

        u = layer_norm(x) * (1.0 + sc1) + sh1
        (a_q, a_kv, a_kr, m_q, m_k, m_v, m_i, m_f, m_o,
         c_b, c_c, c_h, d_q, d_k, d_v) = split_cols(u @ w_in[l])
        y_a = mla_mixer(a_q, a_kv, a_kr, mla_g_q[l], mla_g_kv[l], mla_w_uq[l], mla_w_ukv[l], cos_a, sin_a)
        y_b = mlstm_mixer(m_q, m_k, m_v, m_i + ml_b_i[l], m_f + ml_b_f[l], m_o)
        y_c = short_conv_mixer(c_b, c_c, c_h, sc_w[l])
        lambda_init = 0.8 - 0.6 * math.exp(-0.3 * l)
        y_d = diff_attn_mixer(d_q, d_k, d_v, df_lq1[l], df_lk1[l], df_lq2[l], df_lk2[l], df_g[l],
                              lambda_init, cos_d, sin_d)
        mix = jnp.concatenate([y_a, y_b, y_c, y_d], axis=-1) @ w_out[l]
        x = layer_norm(DN_ALPHA * x + g1 * mix) * ln1_g[l] + ln1_b[l]

        u2 = layer_norm(x) * (1.0 + sc2) + sh2
        ffn = grouped_moe(u2, w_router, b_router, w1[l], w3[l], w2[l])
        x = layer_norm(DN_ALPHA * x + g2 * ffn) * ln2_g[l] + ln2_b[l]
    return x
```

```cpp
#include <hip/hip_runtime.h>
#include <cstdio>
#include <cstdint>

#define GAS __attribute__((address_space(1)))
#define LAS __attribute__((address_space(3)))
typedef unsigned short bf16_t;
typedef short bf16x8 __attribute__((ext_vector_type(8)));
typedef short s16x4 __attribute__((ext_vector_type(4)));
typedef float f32x2 __attribute__((ext_vector_type(2)));
typedef float f32x4 __attribute__((ext_vector_type(4)));
typedef float f32x16 __attribute__((ext_vector_type(16)));
typedef unsigned u32x2 __attribute__((ext_vector_type(2)));
typedef unsigned u32x4 __attribute__((ext_vector_type(4)));
typedef __bf16 bf16x2_t __attribute__((ext_vector_type(2)));

#ifndef MK_MIXER
#define MK_MIXER 3
#endif
constexpr int NB = 8, S = 2048, D = 1024, T = NB * S, DEPTH = 2;
constexpr int NWAVES = 8, NTHREADS = NWAVES * 64;
constexpr int NIN = 3072;
constexpr int ZLD = 2048;
constexpr int WIN_COLS = 2920;
constexpr int NEXP = 16, DEXP = 256;
constexpr float LN_EPS = 1e-5f, RMS_EPS = 1e-6f;
constexpr float DN_ALPHA = 1.4142135623730951f;
constexpr float LOG2E = 1.4426950408889634f;

constexpr size_t MiB = 1u << 20;
constexpr size_t WS_CTL = 0, CTL_ZERO_BYTES = 1 * MiB;
constexpr int CW_BAR = 4096;
constexpr int CW_Q = 8192;
constexpr int CW_CNT = 12288;
constexpr size_t CTL_MOD = 64 * 1024;
constexpr size_t CTL_ROWSS = 512 * 1024;
constexpr size_t WS_BTIN = 2 * MiB, WS_BTUP = 8 * MiB, WS_BTOUT = 9 * MiB, WS_BT13 = 11 * MiB, WS_BT2 = 27 * MiB;
constexpr size_t WS_U = 35 * MiB;
constexpr size_t WS_CLOC = 35 * MiB, WS_CPREV = 51 * MiB, WS_NLOC = 59 * MiB, WS_NPREV = 59 * MiB + 512 * 1024, WS_STAT = 60 * MiB;
constexpr size_t WS_MIX = 67 * MiB, WS_H = 67 * MiB;
constexpr size_t WS_Z = 99 * MiB, WS_PRE = 99 * MiB;
constexpr size_t WS_QM = 163 * MiB, WS_KM = 175 * MiB, WS_VTM = 187 * MiB, WS_QD = 195 * MiB, WS_KD = 203 * MiB, WS_DVT = 211 * MiB, WS_MKT = 219 * MiB, WS_MVT = 227 * MiB;
constexpr size_t WS_YB = 163 * MiB;
constexpr size_t WS_ROPE = 235 * MiB, WS_GATES = 235 * MiB + 512 * 1024, WS_ROUTE = 236 * MiB, WS_LIST = 237 * MiB;
constexpr size_t WS_RSP = 238 * MiB;
constexpr size_t WS_END = 239 * MiB;

constexpr int LDS_BYTES = 147456;
constexpr int LDS_MISC = 131072;

__device__ __forceinline__ unsigned pk2(float lo, float hi) { f32x2 v = {lo, hi}; bf16x2_t b = __builtin_convertvector(v, bf16x2_t); return __builtin_bit_cast(unsigned, b); }
__device__ __forceinline__ float bf2f(unsigned short u) { return __uint_as_float(((unsigned)u) << 16); }
__device__ __forceinline__ float bflo(unsigned w) { return __uint_as_float(w << 16); }
__device__ __forceinline__ float bfhi(unsigned w) { return __uint_as_float(w & 0xffff0000u); }
template <int M> __device__ __forceinline__ float swz_xor(float v) { return __int_as_float(__builtin_amdgcn_ds_swizzle(__float_as_int(v), (M << 10) | 0x1f)); }
__device__ __forceinline__ void xor32_pair(float v, float& lo, float& hi) { auto rr = __builtin_amdgcn_permlane32_swap(__float_as_uint(v), __float_as_uint(v), false, false); lo = __uint_as_float(rr[0]); hi = __uint_as_float(rr[1]); }
__device__ __forceinline__ float xor32_sum(float v) { float a, b; xor32_pair(v, a, b); return a + b; }
__device__ __forceinline__ float xor32_max(float v) { float a, b; xor32_pair(v, a, b); return fmaxf(a, b); }
__device__ __forceinline__ float wave_sum(float v) {
    v += swz_xor<1>(v); v += swz_xor<2>(v); v += swz_xor<4>(v); v += swz_xor<8>(v); v += swz_xor<16>(v); return xor32_sum(v);
}
__device__ __forceinline__ float wave_max(float v) {
    v = fmaxf(v, swz_xor<1>(v)); v = fmaxf(v, swz_xor<2>(v)); v = fmaxf(v, swz_xor<4>(v)); v = fmaxf(v, swz_xor<8>(v)); v = fmaxf(v, swz_xor<16>(v)); return xor32_max(v);
}
__device__ __forceinline__ float ld_coherent(const float* p) { return __hip_atomic_load(p, __ATOMIC_RELAXED, __HIP_MEMORY_SCOPE_AGENT); }
__device__ __forceinline__ float sigmoidf_(float x) { return 1.0f / (1.0f + __expf(-x)); }
__device__ __forceinline__ float siluf_(float x) { return x / (1.0f + __expf(-x)); }
__device__ __forceinline__ int lane_id();
#define LAUNDER(x) asm volatile("" : "+v"(x))
#define LAUNDER_S(x) asm volatile("" : "+s"(x))
#define LDS_WAIT() asm volatile("s_waitcnt lgkmcnt(0)" ::: "memory")
#define VM_WAIT() asm volatile("s_waitcnt vmcnt(0)" ::: "memory")

#define XB_TMO      128
#define XB_XCNT(j)  (256  + 64 * (j))
#define XB_XSUB(j)  (1280 + 64 * (j))
#define XB_XGEN(j)  (2304 + 64 * (j))
#define XB_TOP      3328
#define XB_TOPGEN   3392
#define XCD_BAR_WORDS 3456
#define XB_SPIN_CAP (1u << 22)
__device__ __forceinline__ unsigned xb_ld(unsigned* p)              { return __hip_atomic_load(p, __ATOMIC_RELAXED, __HIP_MEMORY_SCOPE_AGENT); }
__device__ __forceinline__ unsigned xb_add(unsigned* p, unsigned v) { return __hip_atomic_fetch_add(p, v, __ATOMIC_RELAXED, __HIP_MEMORY_SCOPE_AGENT); }
__device__ __forceinline__ unsigned xb_xcc_id() { return (unsigned)__builtin_amdgcn_s_getreg((3 << 11) | 20) & 0xFu; }
#define XB_SPIN(cond, bar) do { unsigned _sp = 0; while (cond) { __builtin_amdgcn_s_sleep(1); \
    if ((++_sp & 255u) == 0u) { if (xb_ld(&(bar)[XB_TMO])) break; if (_sp > XB_SPIN_CAP) { atomicAdd(&(bar)[XB_TMO], 1u); break; } } } } while (0)
struct XcdBarrier { unsigned* bar; unsigned x; volatile LAS unsigned* st; int wave; };
__device__ __forceinline__ int lane_id_() { int l; asm volatile("v_mbcnt_lo_u32_b32 %0, -1, 0\n\tv_mbcnt_hi_u32_b32 %0, -1, %0" : "=v"(l)); return l; }
__device__ __forceinline__ XcdBarrier xcd_barrier_post(unsigned* bar, volatile LAS unsigned* st, int wave) {
    XcdBarrier b; b.bar = bar; b.x = xb_xcc_id(); b.st = st; b.wave = wave;
    if (wave == 0 && lane_id_() == 0) (void)xb_add(&bar[XB_XCNT(b.x)], 1u);
    return b;
}
__device__ __forceinline__ void xcd_barrier_complete(unsigned* bar, unsigned x, unsigned& nloc, unsigned& nx) {
    const unsigned G = gridDim.x * gridDim.y * gridDim.z;
    unsigned sum, cnt, mine, sp = 0u;
    for (;;) {
        sum = 0u; cnt = 0u; mine = 0u;
#pragma unroll
        for (unsigned j = 0; j < 16; ++j) { const unsigned c = xb_ld(&bar[XB_XCNT(j)]); sum += c; cnt += (c > 0u) ? 1u : 0u; mine = (j == x) ? c : mine; }
        if (sum == G) break;
        __builtin_amdgcn_s_sleep(1);
        if ((++sp & 255u) == 0u) { if (xb_ld(&bar[XB_TMO])) break; if (sp > XB_SPIN_CAP) { atomicAdd(&bar[XB_TMO], 1u); break; } }
    }
    nloc = mine > 0u ? mine : 1u; nx = cnt > 0u ? cnt : 1u;
}
__device__ __forceinline__ void xcd_barrier(const XcdBarrier& b) {
    asm volatile("s_waitcnt vmcnt(0)" ::: "memory");
    __syncthreads();
    if (b.wave == 0 && lane_id_() == 0) {
        unsigned* bar = b.bar; asm volatile("" : "+s"(bar));
        __builtin_amdgcn_s_waitcnt(0);
        unsigned nloc = b.st[0], nx = b.st[1];
        unsigned bx = b.x; asm volatile("" : "+s"(bx));
        if (nloc == 0u) { xcd_barrier_complete(bar, bx, nloc, nx); b.st[0] = nloc; b.st[1] = nx; }
        const unsigned old = xb_add(&bar[XB_XSUB(bx)], 1u);
        const unsigned gen = old / nloc;
        if (old + 1u == (gen + 1u) * nloc) {
            __builtin_amdgcn_fence(__ATOMIC_RELEASE, "agent");
            asm volatile("s_waitcnt vmcnt(0)" ::: "memory");
            const unsigned og = xb_add(&bar[XB_TOP], 1u);
            const unsigned tg = og / nx;
            if (og + 1u == (tg + 1u) * nx) xb_add(&bar[XB_TOPGEN], 1u);
            else XB_SPIN(xb_ld(&bar[XB_TOPGEN]) == tg, bar);
            __builtin_amdgcn_fence(__ATOMIC_ACQUIRE, "agent");
            xb_add(&bar[XB_XGEN(bx)], 1u);
            asm volatile("s_waitcnt vmcnt(0)" ::: "memory");
        } else {
            XB_SPIN(xb_ld(&bar[XB_XGEN(bx)]) == gen, bar);
            __builtin_amdgcn_fence(__ATOMIC_ACQUIRE, "agent");
            asm volatile("s_waitcnt vmcnt(0)" ::: "memory");
        }
    }
    __syncthreads();
}

struct Args { const float* in[27]; float* out; unsigned char* ws; int pad0, pad1; };
enum { I_X = 0, I_C, I_WADA, I_BADA, I_WIN, I_GQ, I_GKV, I_WUQ, I_WUKV, I_BI, I_BF, I_SCW, I_LQ1, I_LK1, I_LQ2, I_LK2, I_DFG, I_WOUT, I_LN1G, I_LN1B,
       I_WR, I_BR, I_W1, I_W3, I_W2, I_LN2G, I_LN2B };

struct Frame {
    LAS unsigned char* lds;
    unsigned char* ws;
    unsigned* ctl;
    int tid, lane, wave, bid, G, gw, NGW;
};

__device__ __forceinline__ int lane_id() { return lane_id_(); }
__device__ __forceinline__ Args load_args() {
    typedef const volatile __attribute__((address_space(4))) unsigned long long* kptr_t;
    kptr_t p = (kptr_t)__builtin_amdgcn_kernarg_segment_ptr();
    Args a;
#pragma unroll
    for (int i = 0; i < 27; ++i) a.in[i] = (const float*)p[i];
    a.out = (float*)p[27]; a.ws = (unsigned char*)p[28]; a.pad0 = 0; a.pad1 = 0;
    return a;
}
__device__ __forceinline__ Frame phase_frame(const Frame& F0) { Frame F = F0; LAUNDER_S(F.wave); LAUNDER_S(F.bid); LAUNDER_S(F.G); F.gw = F.bid * NWAVES + F.wave; F.NGW = F.G * NWAVES; F.lane = lane_id(); LAUNDER(F.lane); F.tid = F.wave * 64 + F.lane; return F; }

__device__ __forceinline__ f32x4 mod4p(const unsigned char* ws, const float* bada, int l, int b, int idx) {
    const float* M = (const float*)(ws + CTL_MOD) + (size_t)(l * 8 + b) * 6144 + idx;
    const float* Bv = bada + (size_t)l * 6144 + idx;
    return *(const f32x4*)M + *(const f32x4*)Bv;
}
__device__ __forceinline__ f32x4 mod4(const Args& a, int l, int b, int idx) { return mod4p(a.ws, a.in[I_BADA], l, b, idx); }

__device__ __forceinline__ void ln_stats(const f32x4 (&v)[4], float& mean, float& rstd) {
    float s = 0.f;
#pragma unroll
    for (int j = 0; j < 4; ++j) s += (v[j].x + v[j].y) + (v[j].z + v[j].w);
    mean = wave_sum(s) * (1.f / D);
    float s2 = 0.f;
#pragma unroll
    for (int j = 0; j < 4; ++j) { const f32x4 d = v[j] - mean; s2 += (d.x * d.x + d.y * d.y) + (d.z * d.z + d.w * d.w); }
    rstd = 1.0f / sqrtf(wave_sum(s2) * (1.f / D) + LN_EPS);
}

__device__ __forceinline__ void lnmod_row(const Args& a, const Frame& F, int l, int which  , const f32x4 (&v)[4], int b, bf16_t* urow) {
    float mean, rstd; ln_stats(v, mean, rstd);
#pragma unroll
    for (int j = 0; j < 4; ++j) {
        const int c = 4 * F.lane + 256 * j;
        const f32x4 sh = mod4(a, l, b, which * 3072 + c), sc = mod4(a, l, b, which * 3072 + 1024 + c);
        const f32x4 xn = (v[j] - mean) * rstd;
        const f32x4 u = xn * (sc + 1.0f) + sh;
        u32x2 o; o.x = pk2(u.x, u.y); o.y = pk2(u.z, u.w);
        *(u32x2*)(urow + c) = o;
    }
}

template <class SrcF>
__device__ __forceinline__ void transpose_item(const SrcF& src, bf16_t* dst, int Kd, int k0, int n0, LAS float* scr, int lane) {
#pragma unroll 8
    for (int i = 0; i < 32; ++i) { const int kk = 2 * i + (lane >> 5); scr[kk * 33 + (lane & 31)] = src(k0 + kk, n0 + (lane & 31)); }
    LDS_WAIT(); asm volatile("" ::: "memory");
    const int c = lane & 7;
#pragma unroll
    for (int j = 0; j < 4; ++j) { const int n = (lane >> 3) + 8 * j; const LAS float* s = scr + (8 * c) * 33 + n;
        u32x4 o; o.x = pk2(s[0 * 33], s[1 * 33]); o.y = pk2(s[2 * 33], s[3 * 33]); o.z = pk2(s[4 * 33], s[5 * 33]); o.w = pk2(s[6 * 33], s[7 * 33]);
        *(u32x4*)(dst + (size_t)(n0 + n) * Kd + k0 + 8 * c) = o; }
    LDS_WAIT(); asm volatile("" ::: "memory");
}

__device__ __forceinline__ int zsrc_col(int n) {
    if (n < 352) return n;
    if (n < 360) return 1120 + (n - 352);
    if (n < 512) return -1;
    if (n < 768) return 352 + (n - 512);
    if (n < 1024) return 608 + (n - 768);
    if (n < 1280) return 864 + (n - 1024);
    if (n < 1536) return 1128 + (n - 1280);
    if (n < 1792) return 1384 + (n - 1536);
    if (n < 2048) return 1640 + (n - 1792);
    if (n < 2304) return 1896 + (n - 2048);
    if (n < 2560) return 2152 + (n - 2304);
    if (n < 2816) return 2408 + (n - 2560);
    return 2664 + (n - 2816);
}

struct SrcIn { const float* W; __device__ __forceinline__ float operator()(int k, int n) const { const int c = zsrc_col(n); return c >= 0 ? W[(size_t)k * WIN_COLS + c] : 0.f; } };
struct SrcUp { const float* Wq; const float* Wkv; const float* gq; const float* gkv;
    __device__ __forceinline__ float operator()(int k, int n) const {
        if (n < 384) { if (k >= 192) return 0.f; const int col = (n < 256) ? ((n >> 6) * 96 + (n & 63)) : (((n - 256) >> 5) * 96 + 64 + ((n - 256) & 31)); return gq[k] * Wq[(size_t)k * 384 + col]; }
        if (n < 512) return 0.f;
        if (k < 192 || k >= 320) return 0.f;
        const int kk = k - 192; const int m = n - 512; const int col = (m < 256) ? ((m >> 6) * 128 + (m & 63)) : (((m - 256) >> 6) * 128 + 64 + ((m - 256) & 63));
        return gkv[kk] * Wkv[(size_t)kk * 512 + col];
    } };
struct SrcPlain { const float* W; int N; __device__ __forceinline__ float operator()(int k, int n) const { return W[(size_t)k * N + n]; } };
struct Src13 { const float* W1; const float* W3;
    __device__ __forceinline__ float operator()(int k, int j) const { const int t = j >> 8, w = j & 255; return (w < 128) ? W1[(size_t)k * 256 + t * 128 + w] : W3[(size_t)k * 256 + t * 128 + (w - 128)]; } };

__device__ __forceinline__ void convert_weights(const Args& a, const Frame& F0, int l) {
    const Frame F = phase_frame(F0);
    LAS float* scr = (LAS float*)(F.lds + F.wave * 16384);
    constexpr int I_IN = (1024 / 64) * (NIN / 32);
    constexpr int I_UP = (384 / 64) * (1024 / 32);
    constexpr int I_OUT = (1024 / 64) * (1024 / 32);
    constexpr int I_13 = NEXP * (1024 / 64) * (512 / 32);
    constexpr int I_2 = NEXP * (256 / 64) * (1024 / 32);
    constexpr int NITEMS = I_IN + I_UP + I_OUT + I_13 + I_2;
    bf16_t* BtIn = (bf16_t*)(a.ws + WS_BTIN); bf16_t* BtUp = (bf16_t*)(a.ws + WS_BTUP); bf16_t* BtOut = (bf16_t*)(a.ws + WS_BTOUT);
    bf16_t* Bt13 = (bf16_t*)(a.ws + WS_BT13); bf16_t* Bt2 = (bf16_t*)(a.ws + WS_BT2);
    for (int it = F.gw; it < NITEMS; it += F.NGW) {
        int r = it;
        if (r < I_IN) { const int nblk = NIN / 32; SrcIn s{a.in[I_WIN] + (size_t)l * 1024 * WIN_COLS}; transpose_item(s, BtIn, 1024, 64 * (r / nblk), 32 * (r % nblk), scr, F.lane); continue; } r -= I_IN;
        if (r < I_UP) { const int nblk = 1024 / 32; SrcUp s{a.in[I_WUQ] + (size_t)l * 192 * 384, a.in[I_WUKV] + (size_t)l * 128 * 512, a.in[I_GQ] + l * 192, a.in[I_GKV] + l * 128};
            transpose_item(s, BtUp, 384, 64 * (r / nblk), 32 * (r % nblk), scr, F.lane); continue; } r -= I_UP;
        if (r < I_OUT) { const int nblk = 1024 / 32; SrcPlain s{a.in[I_WOUT] + (size_t)l * 1024 * 1024, 1024}; transpose_item(s, BtOut, 1024, 64 * (r / nblk), 32 * (r % nblk), scr, F.lane); continue; } r -= I_OUT;
        if (r < I_13) { const int per = (1024 / 64) * (512 / 32); const int e = r / per, q = r % per; const int nblk = 512 / 32;
            Src13 s{a.in[I_W1] + ((size_t)l * NEXP + e) * 1024 * 256, a.in[I_W3] + ((size_t)l * NEXP + e) * 1024 * 256};
            transpose_item(s, Bt13 + (size_t)e * 512 * 1024, 1024, 64 * (q / nblk), 32 * (q % nblk), scr, F.lane); continue; } r -= I_13;
        { const int per = (256 / 64) * (1024 / 32); const int e = r / per, q = r % per; const int nblk = 1024 / 32;
            SrcPlain s{a.in[I_W2] + ((size_t)l * NEXP + e) * 256 * 1024, 1024};
            transpose_item(s, Bt2 + (size_t)e * 1024 * 256, 256, 64 * (q / nblk), 32 * (q % nblk), scr, F.lane); }
    }
}

__device__ __forceinline__ void mod_gemv(const Args& a, const Frame& F0) {
    const Frame F = phase_frame(F0);
    LAS float* sl = (LAS float*)F.lds;
    LAS float* red = (LAS float*)(F.lds + 32768);
    float* MOD = (float*)(a.ws + CTL_MOD);
    __syncthreads();
    for (int i = F.tid; i < 8 * 1024; i += NTHREADS) sl[i] = siluf_(a.in[I_C][i]);
    __syncthreads();
    const int col = F.tid & 63, kg = F.tid >> 6;
    for (int u = F.bid; u < 192; u += F.G) {
        const int l = u / 96, n = (u % 96) * 64 + col;
        float acc[8];
#pragma unroll
        for (int b = 0; b < 8; ++b) acc[b] = 0.f;
        const float* W = a.in[I_WADA] + ((size_t)l * 1024 + kg * 128) * 6144 + n;
#pragma unroll 4
        for (int kk = 0; kk < 128; ++kk) { const float w = W[(size_t)kk * 6144];
#pragma unroll
            for (int b = 0; b < 8; ++b) acc[b] += sl[b * 1024 + kg * 128 + kk] * w; }
#pragma unroll
        for (int b = 0; b < 8; ++b) red[(kg * 8 + b) * 64 + col] = acc[b];
        __syncthreads();
        { const int b = F.tid >> 6; float s = 0.f;
#pragma unroll
          for (int g = 0; g < 8; ++g) s += red[(g * 8 + b) * 64 + col];
          MOD[(size_t)(l * 8 + b) * 6144 + n] = s; }
        __syncthreads();
    }
}

__device__ __forceinline__ void rope_table(const Args& a, const Frame& F0) {
    const Frame F = phase_frame(F0);
    f32x2* R = (f32x2*)(a.ws + WS_ROPE);
    for (int i = F.bid * NTHREADS + F.tid; i < S * 16; i += F.G * NTHREADS) {
        const int s = i >> 4, f = i & 15;
        const float inv = 1.0f / powf(10000.0f, (float)(2 * f) / 32.0f);
        const float ang = (float)s * inv;
        R[i] = (f32x2){(float)cos((double)ang), (float)sin((double)ang)};
    }
}


namespace pg8 {
constexpr int BM = 256, BK = 64, HALF = 128, HTB = HALF * BK * 2, NXCD = 8, WGM = 8;
__host__ __device__ __forceinline__ int lds_byte(int r, int c) { const int st = (r >> 4) * 2 + (c >> 5), rr = r & 15, cc = c & 31, ob = rr * 64 + cc * 2; return st * 1024 + (ob ^ (((ob >> 9) & 1) << 5)); }
__host__ __device__ __forceinline__ void stage_rc(int b, int& R, int& C) { const int st = b / 1024, sb = b % 1024, swz = sb ^ (((sb >> 9) & 1) << 5); R = (st >> 1) * 16 + swz / 64; C = (st & 1) * 32 + (swz % 64) / 2; }

struct Unit { int pm, pn; long aoff, boff; int x0, x1; };
struct Gemm { const bf16_t* A; const bf16_t* Bt; int lda; int K; const int* rows; };

struct StaticOrder {
    int nM, nN, nwg, G, c; int lda, K;
    __device__ void init(int M, int N, int lda_, int K_, int G_, int c_) { nM = M / BM; nN = N / BM; nwg = nM * nN; G = G_; c = c_; lda = lda_; K = K_; }
    __device__ bool next(int i, Unit& u) const {
        const long L = (long)i * G + c; if (L >= nwg) return false;
        int wgid = (int)L; { const int q = nwg / NXCD, r = nwg % NXCD, xcd = wgid % NXCD, off = wgid / NXCD; wgid = (xcd < r ? xcd * (q + 1) : r * (q + 1) + (xcd - r) * q) + off; }
        const int nig = WGM * nN, gid = wgid / nig, fm = gid * WGM, gsz = (nM - fm) < WGM ? (nM - fm) : WGM;
        u.pm = fm + ((wgid % nig) % gsz); u.pn = (wgid % nig) / gsz;
        u.aoff = (long)u.pm * BM * lda; u.boff = (long)u.pn * BM * K; u.x0 = 0; u.x1 = 0; return true;
    }
};

template <class Epi, class Sched, bool GATHER>
__device__ __forceinline__ void gemm_phase(LAS unsigned char* lds, int wave_idx, const Gemm g, const Sched& S, const Epi& E) {
    int lane = lane_id(); LAUNDER(lane);
    int wid = wave_idx; LAUNDER_S(wid); const int tid = wid * 64 + lane;
    const int wr = wid >> 2, wc = wid & 3, fr = lane & 15, fq = lane >> 4;
    int K = g.K; LAUNDER_S(K); const int nt = K / BK;
    unsigned voffB[2];
#pragma unroll
    for (int i = 0; i < 2; ++i) { int R_, C_; stage_rc(tid * 16 + i * 8192, R_, C_); voffB[i] = (unsigned)(R_ * K + C_) * 2u; }
    unsigned vA[2][2];
    const size_t kstep = (size_t)(BK * 2);
    const size_t hstepB = (size_t)HALF * K * 2;
    const unsigned ldsw = (unsigned)wid * 1024u;
    const int aoff = lds_byte(wr * 64 + fr, fq * 8), boff = lds_byte(wc * 32 + fr, fq * 8);
#define PG8_SA(b, h) (((b) * 2 + (h)) * HTB)
#define PG8_SB(b, h) ((4 + (b) * 2 + (h)) * HTB)
#define PG8_STAGE_B(bufoff, gbase) do { _Pragma("unroll") for (int _i = 0; _i < 2; ++_i) \
        __builtin_amdgcn_global_load_lds((const unsigned*)((const char*)(gbase) + voffB[_i]), (LAS unsigned*)(lds + (bufoff) + ldsw + _i * 8192), 16, 0, 0); } while (0)
#define PG8_STAGE_A(bufoff, gbase, vo, h) do { _Pragma("unroll") for (int _i = 0; _i < 2; ++_i) \
        __builtin_amdgcn_global_load_lds((const unsigned*)((const char*)(gbase) + (vo)[h][_i]), (LAS unsigned*)(lds + (bufoff) + ldsw + _i * 8192), 16, 0, 0); } while (0)
#define PG8_LDA(dst, b, h) do { _Pragma("unroll") for (int m = 0; m < 4; ++m) _Pragma("unroll") for (int k = 0; k < 2; ++k) dst[m][k] = *(const LAS bf16x8*)(lds + PG8_SA(b, h) + aoff + m * 2048 + k * 1024); } while (0)
#define PG8_LDB(dst, b, h) do { _Pragma("unroll") for (int n = 0; n < 2; ++n) _Pragma("unroll") for (int k = 0; k < 2; ++k) dst[n][k] = *(const LAS bf16x8*)(lds + PG8_SB(b, h) + boff + n * 2048 + k * 1024); } while (0)
#define PG8_MMA(ai, bj, At, Bt) do { __builtin_amdgcn_s_setprio(1); _Pragma("unroll") for (int m = 0; m < 4; ++m) _Pragma("unroll") for (int n = 0; n < 2; ++n) _Pragma("unroll") for (int k = 0; k < 2; ++k) \
        acc[ai][bj][m][n] = __builtin_amdgcn_mfma_f32_16x16x32_bf16(Bt[n][k], At[m][k], acc[ai][bj][m][n], 0, 0, 0); __builtin_amdgcn_s_setprio(0); } while (0)
#define PG8_WAIT_V(n) asm volatile("s_waitcnt vmcnt(" #n ")" ::: "memory")
#define PG8_WAIT_L(n) asm volatile("s_waitcnt lgkmcnt(" #n ")" ::: "memory")
#define PG8_BAR __builtin_amdgcn_s_barrier()
#define PG8_SCHED __builtin_amdgcn_sched_barrier(0)
#define PG8_AOFFS(dst, u) do { _Pragma("unroll") for (int _h = 0; _h < 2; ++_h) _Pragma("unroll") for (int _i = 0; _i < 2; ++_i) { int _R, _C; stage_rc(tid * 16 + _i * 8192, _R, _C); \
        if (GATHER) { const int _ri = _h * HALF + _R; const int _row = (_ri < (u).x1) ? (g.rows[(u).x0 + _ri] >> 1) : 0; dst[_h][_i] = (unsigned)((size_t)_row * g.lda + _C) * 2u; } \
        else dst[_h][_i] = (unsigned)((_h * HALF + _R) * g.lda + _C) * 2u; } } while (0)
    Unit cur, nxt; int ui = 0;
    if (!S.next(0, cur)) return;
    f32x4 acc[2][2][4][2];
#pragma unroll
    for (int a = 0; a < 2; ++a)
#pragma unroll
        for (int b = 0; b < 2; ++b)
#pragma unroll
            for (int m = 0; m < 4; ++m)
#pragma unroll
                for (int n = 0; n < 2; ++n) acc[a][b][m][n] = (f32x4){0.f, 0.f, 0.f, 0.f};
    bf16x8 At[4][2], B0[2][2], B1[2][2];
    const char* cA = (const char*)g.A + (GATHER ? (size_t)0 : (size_t)cur.aoff * 2); const char* cB = (const char*)g.Bt + (size_t)cur.boff * 2;
    PG8_AOFFS(vA, cur);
    PG8_STAGE_B(PG8_SB(0, 0), cB); PG8_STAGE_B(PG8_SB(0, 1), cB + hstepB); PG8_STAGE_A(PG8_SA(0, 0), cA, vA, 0); PG8_STAGE_A(PG8_SA(0, 1), cA, vA, 1);
    if (wr == 1) PG8_BAR;
    PG8_WAIT_V(2); PG8_BAR;
    PG8_STAGE_B(PG8_SB(1, 0), cB + kstep); PG8_STAGE_A(PG8_SA(1, 0), cA + kstep, vA, 0); PG8_STAGE_B(PG8_SB(1, 1), cB + hstepB + kstep);
    PG8_WAIT_V(6); PG8_BAR;
    for (;;) {
        const bool has_next = S.next(ui + 1, nxt);
        const char* nA = has_next ? (const char*)g.A + (GATHER ? (size_t)0 : (size_t)nxt.aoff * 2) : cA; const char* nB = has_next ? (const char*)g.Bt + (size_t)nxt.boff * 2 : cB;
#pragma unroll 1
        for (int t = 0; t < nt; t += 2) {
            const bool last = (t == nt - 2);
            const char* a1 = cA + (size_t)(t + 1) * kstep;
            const char* a2 = last ? nA : cA + (size_t)(t + 2) * kstep; const char* b2 = last ? nB : cB + (size_t)(t + 2) * kstep;
            const char* a3 = a2 + kstep; const char* b3 = b2 + kstep;
            PG8_LDB(B0, 0, 0); PG8_LDB(B1, 0, 1); PG8_SCHED; PG8_LDA(At, 0, 0); PG8_STAGE_A(PG8_SA(1, 1), a1, vA, 1);
            PG8_WAIT_V(8); PG8_WAIT_L(0); PG8_BAR; PG8_MMA(0, 0, At, B0); PG8_MMA(0, 1, At, B1); PG8_BAR; PG8_SCHED;
            if (GATHER) { if (last && has_next) { PG8_AOFFS(vA, nxt); } }
            PG8_LDA(At, 0, 1); PG8_STAGE_B(PG8_SB(0, 0), b2); PG8_STAGE_B(PG8_SB(0, 1), b2 + hstepB); PG8_STAGE_A(PG8_SA(0, 0), a2, vA, 0);
            PG8_WAIT_V(8); PG8_WAIT_L(0); PG8_BAR; PG8_MMA(1, 0, At, B0); PG8_MMA(1, 1, At, B1); PG8_BAR; PG8_SCHED;
            PG8_LDB(B0, 1, 0); PG8_LDB(B1, 1, 1); PG8_SCHED; PG8_LDA(At, 1, 0); PG8_STAGE_A(PG8_SA(0, 1), a2, vA, 1);
            PG8_WAIT_V(8); PG8_WAIT_L(0); PG8_BAR; PG8_MMA(0, 0, At, B0); PG8_MMA(0, 1, At, B1); PG8_BAR; PG8_SCHED;
            PG8_LDA(At, 1, 1); PG8_STAGE_B(PG8_SB(1, 0), b3); PG8_STAGE_B(PG8_SB(1, 1), b3 + hstepB); PG8_STAGE_A(PG8_SA(1, 0), a3, vA, 0);
            PG8_WAIT_V(8); PG8_WAIT_L(0); PG8_BAR; PG8_MMA(1, 0, At, B0); PG8_MMA(1, 1, At, B1); PG8_BAR; PG8_SCHED;
        }
        { const int el = lane_id(); E(acc, cur, wr, wc, el & 15, el >> 4); }
        if (!has_next) break;
#pragma unroll
        for (int a = 0; a < 2; ++a)
#pragma unroll
            for (int b = 0; b < 2; ++b)
#pragma unroll
                for (int m = 0; m < 4; ++m)
#pragma unroll
                    for (int n = 0; n < 2; ++n) acc[a][b][m][n] = (f32x4){0.f, 0.f, 0.f, 0.f};
        cur = nxt; cA = nA; cB = nB; ++ui;
    }
    PG8_WAIT_V(0);
    if (wr == 0) PG8_BAR;
    PG8_BAR;
#undef PG8_SA
#undef PG8_SB
#undef PG8_STAGE_A
#undef PG8_STAGE_B
#undef PG8_LDA
#undef PG8_LDB
#undef PG8_MMA
#undef PG8_WAIT_V
#undef PG8_WAIT_L
#undef PG8_BAR
#undef PG8_SCHED
#undef PG8_AOFFS
}
}


__device__ __forceinline__ int perm_s(int s) { return (s & ~12) | (((s >> 2) & 1) << 3) | (((s >> 3) & 1) << 2); }
constexpr float QS_MLA = 0.10206207261596577f * LOG2E;
constexpr float QS_DF = 0.17677669529663687f * LOG2E;

struct EpiIn {
    unsigned char* ws; const float* b_i; const float* b_f; int layer;
    __device__ __forceinline__ void operator()(const f32x4 (&acc)[2][2][4][2], const pg8::Unit& u, int wr, int wc, int fr, int fq) const {
        const int pn = u.pn, b = u.pm >> 3;
        bf16_t* Z = (bf16_t*)(ws + WS_Z);
        const f32x2* ROPE = (const f32x2*)(ws + WS_ROPE);
        int zbase = -1;
        if (pn <= 3) zbase = pn * 256; else if (pn >= 5 && pn <= 8) zbase = (pn - 1) * 256;
#pragma unroll
        for (int ai = 0; ai < 2; ++ai)
#pragma unroll
            for (int m = 0; m < 4; ++m) {
                const int r = u.pm * 256 + ai * 128 + wr * 64 + m * 16 + fr, s = r & (S - 1);
                if (zbase >= 0) {
#pragma unroll
                    for (int bj = 0; bj < 2; ++bj)
#pragma unroll
                        for (int n = 0; n < 2; ++n) { const f32x4 v = acc[ai][bj][m][n]; u32x2 o; o.x = pk2(v.x, v.y); o.y = pk2(v.z, v.w);
                            *(u32x2*)(Z + (size_t)r * ZLD + zbase + bj * 128 + wc * 32 + n * 16 + fq * 4) = o; }
                }
                if (pn <= 1) {
                    float sq = 0.f, skv = 0.f;
#pragma unroll
                    for (int bj = 0; bj < 2; ++bj) {
                        const int cb = pn * 256 + bj * 128 + wc * 32;
                        float t = 0.f;
#pragma unroll
                        for (int n = 0; n < 2; ++n) { const f32x4 v = acc[ai][bj][m][n]; t += (v.x * v.x + v.y * v.y) + (v.z * v.z + v.w * v.w); }
                        if (cb < 192) sq += t; else if (cb < 320) skv += t;
                    }
                    sq += swz_xor<16>(sq); sq = xor32_sum(sq); skv += swz_xor<16>(skv); skv = xor32_sum(skv);
                    if (fq == 0) *(f32x2*)((float*)(ws + WS_RSP) + ((size_t)r * 8 + pn * 4 + wc) * 2) = (f32x2){sq, skv};
                }
                if (pn == 1 && wc == 2) {
                    const f32x4 x1 = acc[ai][0][m][0], x2 = acc[ai][0][m][1];
                    float o1[4], o2[4];
#pragma unroll
                    for (int j = 0; j < 4; ++j) { const f32x2 cs = ROPE[s * 16 + fq * 4 + j]; o1[j] = x1[j] * cs.x - x2[j] * cs.y; o2[j] = x1[j] * cs.y + x2[j] * cs.x; }
                    u32x2 w1; w1.x = pk2(o1[0], o1[1]); w1.y = pk2(o1[2], o1[3]); u32x2 w2; w2.x = pk2(o2[0], o2[1]); w2.y = pk2(o2[2], o2[3]);
                    bf16_t* KM = (bf16_t*)(ws + WS_KM);
#pragma unroll
                    for (int h = 0; h < 4; ++h) { bf16_t* kr = KM + ((size_t)(b * 4 + h) * S + s) * 96 + 64 + fq * 4; *(u32x2*)kr = w1; *(u32x2*)(kr + 16) = w2; }
                }
                if (pn == 1 && wc == 3 && fq < 2) {
                    const f32x4 v = acc[ai][0][m][0]; const float* bias = (fq == 0 ? b_i : b_f) + layer * 4;
                    float* G = (float*)(ws + WS_GATES) + (size_t)r * 8 + fq * 4;
                    *(f32x4*)G = (f32x4){v.x + bias[0], v.y + bias[1], v.z + bias[2], v.w + bias[3]};
                }
                if (pn == 3 || pn == 4 || pn == 11) {
                    bf16_t* XT = (bf16_t*)(ws + (pn == 3 ? WS_MKT : (pn == 4 ? WS_MVT : WS_DVT)));
                    const int sp = perm_s(s);
#pragma unroll
                    for (int bj = 0; bj < 2; ++bj)
#pragma unroll
                        for (int n = 0; n < 2; ++n) { const f32x4 v = acc[ai][bj][m][n];
                            const int col = bj * 128 + wc * 32 + n * 16 + fq * 4;
#pragma unroll
                            for (int j = 0; j < 4; ++j) { const int c = col + j; XT[((size_t)(b * 4 + (c >> 6)) * 64 + (c & 63)) * S + sp] = (bf16_t)(pk2(v[j], 0.f) & 0xffffu); } }
                }
                if (pn == 9 || pn == 10) {
                    bf16_t* XD = (bf16_t*)(ws + (pn == 9 ? WS_QD : WS_KD)); const float sc = (pn == 9) ? QS_DF : 1.0f;
#pragma unroll
                    for (int bj = 0; bj < 2; ++bj) {
                        const f32x4 x1 = acc[ai][bj][m][0], x2 = acc[ai][bj][m][1];
                        float o1[4], o2[4];
#pragma unroll
                        for (int j = 0; j < 4; ++j) { const f32x2 cs = ROPE[s * 16 + fq * 4 + j]; o1[j] = (x1[j] * cs.x - x2[j] * cs.y) * sc; o2[j] = (x1[j] * cs.y + x2[j] * cs.x) * sc; }
                        u32x2 w1; w1.x = pk2(o1[0], o1[1]); w1.y = pk2(o1[2], o1[3]); u32x2 w2; w2.x = pk2(o2[0], o2[1]); w2.y = pk2(o2[2], o2[3]);
                        bf16_t* dst = XD + ((size_t)(b * 8 + bj * 4 + wc) * S + s) * 32 + fq * 4; *(u32x2*)dst = w1; *(u32x2*)(dst + 16) = w2;
                    }
                }
            }
    }
};

struct EpiUp {
    unsigned char* ws; int layer;
    __device__ __forceinline__ void operator()(const f32x4 (&acc)[2][2][4][2], const pg8::Unit& u, int wr, int wc, int fr, int fq) const {
        const int pn = u.pn, b = u.pm >> 3;
        const f32x2* ROPE = (const f32x2*)(ws + WS_ROPE);
        bf16_t* QM = (bf16_t*)(ws + WS_QM); bf16_t* KM = (bf16_t*)(ws + WS_KM); bf16_t* VT = (bf16_t*)(ws + WS_VTM);
#pragma unroll
        for (int ai = 0; ai < 2; ++ai)
#pragma unroll
            for (int m = 0; m < 4; ++m) {
                const int r = u.pm * 256 + ai * 128 + wr * 64 + m * 16 + fr, s = r & (S - 1);
                f32x2 ss = (f32x2){0.f, 0.f};
                { const f32x4* rp = (const f32x4*)((const float*)(ws + WS_RSP) + (size_t)r * 16);
#pragma unroll
                  for (int q4 = 0; q4 < 4; ++q4) { const f32x4 t4 = rp[q4]; ss.x += t4.x + t4.z; ss.y += t4.y + t4.w; } }
                const float rq = 1.0f / sqrtf(ss.x * (1.0f / 192.0f) + RMS_EPS), rkv = 1.0f / sqrtf(ss.y * (1.0f / 128.0f) + RMS_EPS);
                if (pn == 0 || pn == 2) {
                    bf16_t* X = (pn == 0) ? QM : KM; const float sc = (pn == 0) ? rq * QS_MLA : rkv;
#pragma unroll
                    for (int bj = 0; bj < 2; ++bj)
#pragma unroll
                        for (int n = 0; n < 2; ++n) { const f32x4 v = acc[ai][bj][m][n] * sc; const int col = bj * 128 + wc * 32 + n * 16 + fq * 4;
                            u32x2 o; o.x = pk2(v.x, v.y); o.y = pk2(v.z, v.w);
                            *(u32x2*)(X + ((size_t)(b * 4 + (col >> 6)) * S + s) * 96 + (col & 63)) = o; }
                } else if (pn == 1) {
                    const f32x4 x1 = acc[ai][0][m][0], x2 = acc[ai][0][m][1]; const float sc = rq * QS_MLA;
                    float o1[4], o2[4];
#pragma unroll
                    for (int j = 0; j < 4; ++j) { const f32x2 cs = ROPE[s * 16 + fq * 4 + j]; o1[j] = (x1[j] * cs.x - x2[j] * cs.y) * sc; o2[j] = (x1[j] * cs.y + x2[j] * cs.x) * sc; }
                    u32x2 w1; w1.x = pk2(o1[0], o1[1]); w1.y = pk2(o1[2], o1[3]); u32x2 w2; w2.x = pk2(o2[0], o2[1]); w2.y = pk2(o2[2], o2[3]);
                    bf16_t* dst = QM + ((size_t)(b * 4 + wc) * S + s) * 96 + 64 + fq * 4; *(u32x2*)dst = w1; *(u32x2*)(dst + 16) = w2;
                } else {
                    const int sp = perm_s(s);
#pragma unroll
                    for (int bj = 0; bj < 2; ++bj)
#pragma unroll
                        for (int n = 0; n < 2; ++n) { const f32x4 v = acc[ai][bj][m][n] * rkv; const int col = bj * 128 + wc * 32 + n * 16 + fq * 4;
#pragma unroll
                            for (int j = 0; j < 4; ++j) { const int c = col + j; VT[((size_t)(b * 4 + (c >> 6)) * 64 + (c & 63)) * S + sp] = (bf16_t)(pk2(v[j], 0.f) & 0xffffu); } }
                }
            }
    }
};

struct EpiOut {
    unsigned char* ws; const float* bada; const float* xin; int layer;
    __device__ __forceinline__ void operator()(const f32x4 (&acc)[2][2][4][2], const pg8::Unit& u, int wr, int wc, int fr, int fq) const {
        const int b = u.pm >> 3; float* PRE = (float*)(ws + WS_PRE);
#pragma unroll
        for (int bj = 0; bj < 2; ++bj)
#pragma unroll
            for (int n = 0; n < 2; ++n) {
                const int c = u.pn * 256 + bj * 128 + wc * 32 + n * 16 + fq * 4;
                const f32x4 g1 = mod4p(ws, bada, layer, b, 2048 + c);
#pragma unroll
                for (int ai = 0; ai < 2; ++ai)
#pragma unroll
                    for (int m = 0; m < 4; ++m) {
                        const int r = u.pm * 256 + ai * 128 + wr * 64 + m * 16 + fr;
                        const f32x4 xv = *(const f32x4*)(xin + (size_t)r * D + c);
                        *(f32x4*)(PRE + (size_t)r * D + c) = xv * DN_ALPHA + g1 * acc[ai][bj][m][n];
                    }
            }
    }
};


constexpr int MOE_MAXT = 160;
constexpr int LM_NT = 16, LM_TT = 32, LM_VV = 32 + MOE_MAXT;

__device__ __forceinline__ float top2sum4(float a, float b, float c, float d) {
    return fmaxf(fmaxf(fmaxf(a + b, a + c), fmaxf(a + d, b + c)), fmaxf(b + d, c + d));
}
__device__ __forceinline__ void route_select(const float (&lg)[16], const float* br, int& e0, int& e1, float& w0, float& w1) {
    float sc[16], sel[16];
#pragma unroll
    for (int e = 0; e < 16; ++e) { sc[e] = 1.0f / (1.0f + expf(-lg[e])); sel[e] = sc[e] + br[e]; }
    float gs[4];
#pragma unroll
    for (int g = 0; g < 4; ++g) gs[g] = top2sum4(sel[4 * g], sel[4 * g + 1], sel[4 * g + 2], sel[4 * g + 3]);
    int gb = 0; float gv = gs[0];
#pragma unroll
    for (int g = 1; g < 4; ++g) if (gs[g] > gv) { gv = gs[g]; gb = g; }
    float s4[4], c4[4];
#pragma unroll
    for (int i = 0; i < 4; ++i) { s4[i] = gb == 0 ? sel[i] : gb == 1 ? sel[4 + i] : gb == 2 ? sel[8 + i] : sel[12 + i]; c4[i] = gb == 0 ? sc[i] : gb == 1 ? sc[4 + i] : gb == 2 ? sc[8 + i] : sc[12 + i]; }
    int i0 = 0; float v0 = s4[0], cw0 = c4[0];
#pragma unroll
    for (int i = 1; i < 4; ++i) if (s4[i] > v0) { v0 = s4[i]; i0 = i; cw0 = c4[i]; }
    int i1 = -1; float v1 = -INFINITY, cw1 = 0.f;
#pragma unroll
    for (int i = 0; i < 4; ++i) if (i != i0 && s4[i] > v1) { v1 = s4[i]; i1 = i; cw1 = c4[i]; }
    e0 = gb * 4 + i0; e1 = gb * 4 + i1; const float inv = 1.0f / (cw0 + cw1); w0 = cw0 * inv; w1 = cw1 * inv;
}

__device__ __forceinline__ void moe_tile_table(const Frame& F0, int layer) {
    const Frame F = phase_frame(F0);
    volatile LAS unsigned* MISC = (volatile LAS unsigned*)(F.lds + LDS_MISC);
    __syncthreads();
    if (F.tid == 0) {
        int gt = 0;
        for (int e = 0; e < NEXP; ++e) {
            const int cnt = (int)__hip_atomic_load(F.ctl + CW_CNT + 64 * layer + e, __ATOMIC_RELAXED, __HIP_MEMORY_SCOPE_AGENT);
            for (int t = 0; t * 256 < cnt && gt < MOE_MAXT; ++t, ++gt) { MISC[LM_TT + gt] = ((unsigned)e << 16) | (unsigned)t; const int v = cnt - t * 256; MISC[LM_VV + gt] = (unsigned)(v < 256 ? v : 256); }
        }
        MISC[LM_NT] = (unsigned)gt;
    }
    __syncthreads();
}
struct MoeOrder {
    const volatile LAS unsigned* MISC; int G, c, npn, which;
    __device__ bool next(int i, pg8::Unit& u) const {
        const int nt = __builtin_amdgcn_readfirstlane((int)MISC[LM_NT]); const int L = i * G + c; if (L >= nt * npn) return false;
        const int gt = L / npn, pn = L % npn; const unsigned tt = (unsigned)__builtin_amdgcn_readfirstlane((int)MISC[LM_TT + gt]); const int e = (int)(tt >> 16), tile = (int)(tt & 0xffffu);
        u.pm = gt; u.pn = pn; u.x0 = e * T + tile * 256; u.x1 = __builtin_amdgcn_readfirstlane((int)MISC[LM_VV + gt]);
        if (which == 1) { u.aoff = 0; u.boff = ((long)e * 512 + pn * 256) * 1024; }
        else { u.aoff = (long)gt * 256 * 256; u.boff = ((long)e * 1024 + pn * 256) * 256; }
        return true;
    }
};
struct EpiMoe1 {
    unsigned char* ws;
    __device__ __forceinline__ void operator()(const f32x4 (&acc)[2][2][4][2], const pg8::Unit& u, int wr, int wc, int fr, int fq) const {
        bf16_t* H = (bf16_t*)(ws + WS_H); const int* LIST = (const int*)(ws + WS_LIST); const float* ROUTE = (const float*)(ws + WS_ROUTE);
#pragma unroll
        for (int ai = 0; ai < 2; ++ai)
#pragma unroll
            for (int m = 0; m < 4; ++m) {
                const int ri = ai * 128 + wr * 64 + m * 16 + fr;
                float gate = 0.f;
                if (ri < u.x1) { const int code = LIST[u.x0 + ri]; gate = ROUTE[code]; }
#pragma unroll
                for (int n = 0; n < 2; ++n) { const f32x4 a1 = acc[ai][0][m][n], a3 = acc[ai][1][m][n]; f32x4 h;
#pragma unroll
                    for (int j = 0; j < 4; ++j) h[j] = a1[j] / (1.0f + __expf(-a1[j])) * a3[j] * gate;
                    u32x2 o; o.x = pk2(h.x, h.y); o.y = pk2(h.z, h.w);
                    *(u32x2*)(H + ((size_t)u.pm * 256 + ri) * 256 + u.pn * 128 + wc * 32 + n * 16 + fq * 4) = o; }
            }
    }
};
struct EpiMoe2 {
    unsigned char* ws;
    __device__ __forceinline__ void operator()(const f32x4 (&acc)[2][2][4][2], const pg8::Unit& u, int wr, int wc, int fr, int fq) const {
        bf16_t* YB = (bf16_t*)(ws + WS_YB); const int* LIST = (const int*)(ws + WS_LIST);
#pragma unroll
        for (int ai = 0; ai < 2; ++ai)
#pragma unroll
            for (int m = 0; m < 4; ++m) {
                const int ri = ai * 128 + wr * 64 + m * 16 + fr;
                if (ri < u.x1) { const int code = LIST[u.x0 + ri];
#pragma unroll
                    for (int bj = 0; bj < 2; ++bj)
#pragma unroll
                        for (int n = 0; n < 2; ++n) { const f32x4 v = acc[ai][bj][m][n]; u32x2 o; o.x = pk2(v.x, v.y); o.y = pk2(v.z, v.w);
                            *(u32x2*)(YB + (size_t)code * D + u.pn * 256 + bj * 128 + wc * 32 + n * 16 + fq * 4) = o; } }
            }
    }
};


__device__ __forceinline__ int queue_next(const Frame& F, int qi) {
    volatile LAS int* slot = (volatile LAS int*)(F.lds + LDS_MISC + 64);
    __syncthreads();
    if (F.tid == 0) *slot = (int)__hip_atomic_fetch_add(F.ctl + CW_Q + 64 * qi, 1u, __ATOMIC_RELAXED, __HIP_MEMORY_SCOPE_AGENT);
    __syncthreads();
    return __builtin_amdgcn_readfirstlane(*slot);
}

__device__ __forceinline__ int crow(int r, int h) { return (r & 3) + 8 * (r >> 2) + 4 * h; }
template <int DK>
struct AttnLds { static constexpr int KSTR = DK * 2 + 16, VSTR = 144, KB = 64 * KSTR, VB = 64 * VSTR, K0 = 0, K1 = KB, V0 = 2 * KB, V1 = 2 * KB + VB, TOTAL = 2 * KB + 2 * VB; };

template <int DK>
__device__ __forceinline__ void attn_map(const Frame& F, const bf16_t* Qp, const bf16_t* Kp, const bf16_t* VTp, int qb, f32x16 (&o)[2], float& lsum) {
    typedef AttnLds<DK> L;
    constexpr int KS = DK / 16, KPR = DK * 2 / 16;
    const int lane = F.lane, r32 = lane & 31, h = lane >> 5, wave = F.wave, tid = F.tid;
    LAS unsigned char* lds = F.lds;
    const int q = qb * 256 + wave * 32 + r32;
    bf16x8 qf[KS];
#pragma unroll
    for (int s = 0; s < KS; ++s) qf[s] = *(const bf16x8*)(Qp + (size_t)q * DK + s * 16 + h * 8);
    const int NT = 4 * qb + 4, tmax = 4 * qb + (wave >> 1);
    float m_run = -INFINITY, l_run = 0.f;
#pragma unroll
    for (int i = 0; i < 16; ++i) { o[0][i] = 0.f; o[1][i] = 0.f; }
    constexpr int NKP = 64 * KPR;
    const bool k0v = tid < NKP, k1v = (tid + 512) < NKP;
    const int kr0 = tid / KPR, kc0 = tid % KPR, kr1 = (tid + 512) / KPR, kc1 = (tid + 512) % KPR;
    const int vr = tid >> 3, vc = tid & 7;
    u32x4 kreg0, kreg1, vreg;
    kreg0 = (u32x4){0u, 0u, 0u, 0u}; kreg1 = kreg0;
#define ATT_LOAD(t) do { if (k0v) kreg0 = *(const u32x4*)(Kp + ((size_t)(t) * 64 + kr0) * DK + kc0 * 8); if (k1v) kreg1 = *(const u32x4*)(Kp + ((size_t)(t) * 64 + kr1) * DK + kc1 * 8); \
        vreg = *(const u32x4*)(VTp + (size_t)vr * S + (t) * 64 + vc * 8); } while (0)
#define ATT_STORE(buf) do { if (k0v) *(LAS u32x4*)(lds + ((buf) ? L::K1 : L::K0) + kr0 * L::KSTR + kc0 * 16) = kreg0; if (k1v) *(LAS u32x4*)(lds + ((buf) ? L::K1 : L::K0) + kr1 * L::KSTR + kc1 * 16) = kreg1; \
        *(LAS u32x4*)(lds + ((buf) ? L::V1 : L::V0) + vr * L::VSTR + vc * 16) = vreg; } while (0)
    __syncthreads();
    ATT_LOAD(0); ATT_STORE(0);
    __syncthreads();
    for (int t = 0; t < NT; ++t) {
        const int buf = t & 1;
        if (t + 1 < NT) ATT_LOAD(t + 1);
        if (t <= tmax) {
            const LAS unsigned char* kb = lds + (buf ? L::K1 : L::K0) + r32 * L::KSTR + h * 16;
            const LAS unsigned char* vb = lds + (buf ? L::V1 : L::V0) + r32 * L::VSTR + h * 16;
            f32x16 p0, p1;
#pragma unroll
            for (int i = 0; i < 16; ++i) { p0[i] = 0.f; p1[i] = 0.f; }
#pragma unroll
            for (int s = 0; s < KS; ++s) {
                const bf16x8 a0 = *(const LAS bf16x8*)(kb + s * 32), a1 = *(const LAS bf16x8*)(kb + 32 * L::KSTR + s * 32);
                p0 = __builtin_amdgcn_mfma_f32_32x32x16_bf16(a0, qf[s], p0, 0, 0, 0);
                p1 = __builtin_amdgcn_mfma_f32_32x32x16_bf16(a1, qf[s], p1, 0, 0, 0);
            }
            if (t == tmax) {
                const int kbase = t * 64 + 4 * h;
#pragma unroll
                for (int r = 0; r < 16; ++r) { const int kv = kbase + (r & 3) + 8 * (r >> 2); if (kv > q) p0[r] = -INFINITY; if (kv + 32 > q) p1[r] = -INFINITY; }
            }
            float mx = fmaxf(p0[0], p1[0]);
#pragma unroll
            for (int r = 1; r < 16; ++r) mx = fmaxf(mx, fmaxf(p0[r], p1[r]));
            mx = xor32_max(mx);
            const float m_new = fmaxf(m_run, mx), alpha = __builtin_amdgcn_exp2f(m_run - m_new);
            m_run = m_new;
            float rs = 0.f;
#pragma unroll
            for (int r = 0; r < 16; ++r) { p0[r] = __builtin_amdgcn_exp2f(p0[r] - m_new); p1[r] = __builtin_amdgcn_exp2f(p1[r] - m_new); rs += p0[r] + p1[r]; }
            l_run = l_run * alpha + rs;
#pragma unroll
            for (int i = 0; i < 16; ++i) { o[0][i] *= alpha; o[1][i] *= alpha; }
#pragma unroll
            for (int kbk = 0; kbk < 2; ++kbk)
#pragma unroll
                for (int s2 = 0; s2 < 2; ++s2) {
                    u32x4 pw;
                    if (kbk == 0) { pw.x = pk2(p0[8 * s2], p0[8 * s2 + 1]); pw.y = pk2(p0[8 * s2 + 2], p0[8 * s2 + 3]); pw.z = pk2(p0[8 * s2 + 4], p0[8 * s2 + 5]); pw.w = pk2(p0[8 * s2 + 6], p0[8 * s2 + 7]); }
                    else { pw.x = pk2(p1[8 * s2], p1[8 * s2 + 1]); pw.y = pk2(p1[8 * s2 + 2], p1[8 * s2 + 3]); pw.z = pk2(p1[8 * s2 + 4], p1[8 * s2 + 5]); pw.w = pk2(p1[8 * s2 + 6], p1[8 * s2 + 7]); }
                    const bf16x8 bfrag = __builtin_bit_cast(bf16x8, pw);
#pragma unroll
                    for (int db = 0; db < 2; ++db) {
                        const bf16x8 afrag = *(const LAS bf16x8*)(vb + db * 32 * L::VSTR + (kbk * 32 + s2 * 16) * 2);
                        o[db] = __builtin_amdgcn_mfma_f32_32x32x16_bf16(afrag, bfrag, o[db], 0, 0, 0);
                    }
                }
        }
        if (t + 1 < NT) ATT_STORE(buf ^ 1);
        __syncthreads();
    }
#undef ATT_LOAD
#undef ATT_STORE
    lsum = xor32_sum(l_run);
}

__device__ __forceinline__ void mla_unit(const Args& a, const Frame& F, int bh, int qb) {
    const bf16_t* Qp = (const bf16_t*)(a.ws + WS_QM) + (size_t)bh * S * 96;
    const bf16_t* Kp = (const bf16_t*)(a.ws + WS_KM) + (size_t)bh * S * 96;
    const bf16_t* VTp = (const bf16_t*)(a.ws + WS_VTM) + (size_t)bh * 64 * S;
    f32x16 o[2]; float l;
    attn_map<96>(F, Qp, Kp, VTp, qb, o, l);
    const float inv = 1.0f / l;
    const int r32 = F.lane & 31, h = F.lane >> 5, b = bh >> 2, head = bh & 3;
    bf16_t* orow = (bf16_t*)(a.ws + WS_MIX) + ((size_t)b * S + qb * 256 + F.wave * 32 + r32) * D + head * 64;
#pragma unroll
    for (int db = 0; db < 2; ++db)
#pragma unroll
        for (int g = 0; g < 4; ++g) { u32x2 w; w.x = pk2(o[db][4 * g] * inv, o[db][4 * g + 1] * inv); w.y = pk2(o[db][4 * g + 2] * inv, o[db][4 * g + 3] * inv);
            *(u32x2*)(orow + db * 32 + 8 * g + 4 * h) = w; }
}
__device__ __forceinline__ void diff_unit(const Args& a, const Frame& F, int layer, int bh, int qb) {
    const int b = bh >> 2, head = bh & 3;
    const bf16_t* VTp = (const bf16_t*)(a.ws + WS_DVT) + (size_t)bh * 64 * S;
    f32x16 oa[2], ob[2]; float la, lb;
    { const size_t off = ((size_t)(b * 8 + head * 2) * S) * 32; attn_map<32>(F, (const bf16_t*)(a.ws + WS_QD) + off, (const bf16_t*)(a.ws + WS_KD) + off, VTp, qb, oa, la); }
    { const size_t off = ((size_t)(b * 8 + head * 2 + 1) * S) * 32; attn_map<32>(F, (const bf16_t*)(a.ws + WS_QD) + off, (const bf16_t*)(a.ws + WS_KD) + off, VTp, qb, ob, lb); }
    float d1 = 0.f, d2 = 0.f;
    if (F.lane < 32) { d1 = a.in[I_LQ1][layer * 32 + F.lane] * a.in[I_LK1][layer * 32 + F.lane]; d2 = a.in[I_LQ2][layer * 32 + F.lane] * a.in[I_LK2][layer * 32 + F.lane]; }
    d1 = wave_sum(d1); d2 = wave_sum(d2);
    const float lam_init = 0.8f - 0.6f * expf(-0.3f * (float)layer);
    const float lam = expf(d1) - expf(d2) + lam_init;
    const float ia = 1.0f / la, ib = lam / lb;
    float ss = 0.f;
#pragma unroll
    for (int db = 0; db < 2; ++db)
#pragma unroll
        for (int i = 0; i < 16; ++i) { oa[db][i] = oa[db][i] * ia - ob[db][i] * ib; ss += oa[db][i] * oa[db][i]; }
    ss = xor32_sum(ss);
    const float rn = (1.0f / sqrtf(ss * (1.0f / 64.0f) + RMS_EPS)) * (1.0f - lam_init);
    const int r32 = F.lane & 31, h = F.lane >> 5;
    bf16_t* orow = (bf16_t*)(a.ws + WS_MIX) + ((size_t)b * S + qb * 256 + F.wave * 32 + r32) * D + 768 + head * 64;
    const float* gs = a.in[I_DFG] + layer * 64;
#pragma unroll
    for (int db = 0; db < 2; ++db)
#pragma unroll
        for (int g = 0; g < 4; ++g) { const int dv = db * 32 + 8 * g + 4 * h; const f32x4 gv = *(const f32x4*)(gs + dv);
            u32x2 w; w.x = pk2(oa[db][4 * g] * rn * gv.x, oa[db][4 * g + 1] * rn * gv.y); w.y = pk2(oa[db][4 * g + 2] * rn * gv.z, oa[db][4 * g + 3] * rn * gv.w);
            *(u32x2*)(orow + dv) = w; }
}

__device__ __forceinline__ void conv_phase(const Args& a, const Frame& F0, int layer) {
    const Frame F = phase_frame(F0);
    const bf16_t* Z = (const bf16_t*)(a.ws + WS_Z); bf16_t* MIXp = (bf16_t*)(a.ws + WS_MIX); const float* W = a.in[I_SCW] + (size_t)layer * 3 * 256;
    for (int i = F.bid * NTHREADS + F.tid; i < T * 32; i += F.G * NTHREADS) {
        const int t = i >> 5, c8 = (i & 31) * 8, s = t & (S - 1);
        const bf16_t* zr = Z + (size_t)t * ZLD;
        const u32x4 cb = *(const u32x4*)(zr + 1280 + c8);
        float acc[8];
#pragma unroll
        for (int j = 0; j < 8; ++j) acc[j] = 0.f;
#pragma unroll
        for (int w = 0; w < 3; ++w) {
            const int back = 2 - w;
            if (s >= back) {
                const u32x4 cc = *(const u32x4*)(zr - (size_t)back * ZLD + 1536 + c8), ch = *(const u32x4*)(zr - (size_t)back * ZLD + 1792 + c8);
                const f32x4 w0 = *(const f32x4*)(W + w * 256 + c8), w1 = *(const f32x4*)(W + w * 256 + c8 + 4);
                acc[0] += w0.x * bflo(cc.x) * bflo(ch.x); acc[1] += w0.y * bfhi(cc.x) * bfhi(ch.x); acc[2] += w0.z * bflo(cc.y) * bflo(ch.y); acc[3] += w0.w * bfhi(cc.y) * bfhi(ch.y);
                acc[4] += w1.x * bflo(cc.z) * bflo(ch.z); acc[5] += w1.y * bfhi(cc.z) * bfhi(ch.z); acc[6] += w1.z * bflo(cc.w) * bflo(ch.w); acc[7] += w1.w * bfhi(cc.w) * bfhi(ch.w);
            }
        }
        u32x4 o; o.x = pk2(acc[0] * bflo(cb.x), acc[1] * bfhi(cb.x)); o.y = pk2(acc[2] * bflo(cb.y), acc[3] * bfhi(cb.y)); o.z = pk2(acc[4] * bflo(cb.z), acc[5] * bfhi(cb.z)); o.w = pk2(acc[6] * bflo(cb.w), acc[7] * bfhi(cb.w));
        *(u32x4*)(MIXp + (size_t)t * D + 512 + c8) = o;
#if MK_MIXER < 3 || defined(MK_EXP_NOSTAGE3)
        { const u32x4 zz = (u32x4){0u, 0u, 0u, 0u};
#if MK_MIXER < 2
          *(u32x4*)(MIXp + (size_t)t * D + c8) = zz; *(u32x4*)(MIXp + (size_t)t * D + 768 + c8) = zz;
#endif
          *(u32x4*)(MIXp + (size_t)t * D + 256 + c8) = zz; }
#endif
    }
}


constexpr int ML_STR = 144;
constexpr int ML_TILE = 64 * ML_STR;
constexpr int ML_GRP = 4 * ML_TILE + 2048;
__device__ __forceinline__ int unperm_p(int p) { return perm_s(p); }
__device__ __forceinline__ float logsigmoidf_(float x) { return x >= 0.f ? -log1pf(expf(-x)) : x - log1pf(expf(x)); }

__device__ __forceinline__ void ml_gates(const Args& a, int lane, int b, int h, int c, LAS float* vec, float& bc, float& gi) {
    const int t = b * S + c * 64 + lane;
    const float* G = (const float*)(a.ws + WS_GATES) + (size_t)t * 8;
#ifdef MK_EXP_CONSTGATES
    gi = 0.0f; const float lf = -0.01f; (void)G;
#else
    gi = G[h]; const float lf = logsigmoidf_(G[4 + h]);
#endif
    vec[128 + lane] = lf;
    LDS_WAIT(); asm volatile("" ::: "memory");
    float acc = 0.f;
    for (int s = 0; s < 64; ++s) { const float v = vec[128 + s]; acc += (s <= lane) ? v : 0.f; }
    bc = acc;
}

__device__ __forceinline__ void mlstm_stage1(const Args& a, const Frame& F0) {
    const Frame F = phase_frame(F0);
    const int grp = F.wave >> 2, w4 = F.wave & 3, gt = w4 * 64 + F.lane, lane = F.lane, r32 = lane & 31, hh = lane >> 5;
    LAS unsigned char* gl = F.lds + grp * ML_GRP;
    LAS unsigned char* Kt = gl, * Vt = gl + ML_TILE; LAS float* vec = (LAS float*)(gl + 4 * ML_TILE);
    float* CLOC = (float*)(a.ws + WS_CLOC); float* NLOC = (float*)(a.ws + WS_NLOC); float* STAT = (float*)(a.ws + WS_STAT);
    for (int it = F.bid; it < 512; it += F.G) {
        const int u = it * 2 + grp, c = u & 31, bh = u >> 5, b = bh >> 2, h = bh & 3;
        __syncthreads();
        if (w4 == 0) {
            float bc, gi; ml_gates(a, lane, b, h, c, vec, bc, gi);
            vec[lane] = bc; LDS_WAIT(); asm volatile("" ::: "memory");
            const float gtot = vec[63];
            const float we = gtot - bc + gi; const float ml = wave_max(we);
            vec[192 + lane] = expf(we - ml);
            if (lane == 0) { STAT[u * 4] = gtot; STAT[u * 4 + 1] = ml; }
        }
        __syncthreads();
        const bf16_t* KT = (const bf16_t*)(a.ws + WS_MKT) + (size_t)bh * 64 * S + c * 64;
        const bf16_t* VT = (const bf16_t*)(a.ws + WS_MVT) + (size_t)bh * 64 * S + c * 64;
#pragma unroll
        for (int i = 0; i < 2; ++i) {
            const int p = gt + 256 * i, row = p >> 3, pc = p & 7;
            const u32x4 kv = *(const u32x4*)(KT + (size_t)row * S + pc * 8), vv = *(const u32x4*)(VT + (size_t)row * S + pc * 8);
            float ae[8];
#pragma unroll
            for (int j = 0; j < 8; ++j) ae[j] = vec[192 + unperm_p(pc * 8 + j)];
            u32x4 ko; ko.x = pk2(bflo(kv.x) * ae[0], bfhi(kv.x) * ae[1]); ko.y = pk2(bflo(kv.y) * ae[2], bfhi(kv.y) * ae[3]); ko.z = pk2(bflo(kv.z) * ae[4], bfhi(kv.z) * ae[5]); ko.w = pk2(bflo(kv.w) * ae[6], bfhi(kv.w) * ae[7]);
            *(LAS u32x4*)(Kt + row * ML_STR + pc * 16) = ko; *(LAS u32x4*)(Vt + row * ML_STR + pc * 16) = vv;
        }
        __syncthreads();
        if (w4 == 1) {
            float sum = 0.f;
#pragma unroll
            for (int pc = 0; pc < 8; ++pc) { const u32x4 kv = *(const LAS u32x4*)(Kt + lane * ML_STR + pc * 16);
                sum += (bflo(kv.x) + bfhi(kv.x)) + (bflo(kv.y) + bfhi(kv.y)) + (bflo(kv.z) + bfhi(kv.z)) + (bflo(kv.w) + bfhi(kv.w)); }
            NLOC[u * 64 + lane] = sum;
        }
        const int eb = w4 >> 1, db = w4 & 1;
        f32x16 acc;
#pragma unroll
        for (int i = 0; i < 16; ++i) acc[i] = 0.f;
#pragma unroll
        for (int ks = 0; ks < 4; ++ks) {
            const bf16x8 af = *(const LAS bf16x8*)(Vt + (eb * 32 + r32) * ML_STR + ks * 32 + hh * 16);
            const bf16x8 bfg = *(const LAS bf16x8*)(Kt + (db * 32 + r32) * ML_STR + ks * 32 + hh * 16);
            acc = __builtin_amdgcn_mfma_f32_32x32x16_bf16(af, bfg, acc, 0, 0, 0);
        }
#pragma unroll
        for (int r = 0; r < 16; ++r) CLOC[(size_t)u * 4096 + (eb * 32 + crow(r, hh)) * 64 + db * 32 + r32] = acc[r];
    }
}

__device__ __forceinline__ void mlstm_scan_unit(const Args& a, const Frame& F, int su) {
    const int bh = su >> 3, part = su & 7, idx = part * 512 + F.tid;
    const float* CLOC = (const float*)(a.ws + WS_CLOC); const float* NLOC = (const float*)(a.ws + WS_NLOC); float* STAT = (float*)(a.ws + WS_STAT);
    bf16_t* CPREV = (bf16_t*)(a.ws + WS_CPREV); float* NPREV = (float*)(a.ws + WS_NPREV);
    float Cst = 0.f, nst = 0.f, mst = 0.f;
    const bool do_n = (part == 0) && (F.tid < 64);
    for (int c = 0; c < 32; ++c) {
        const int u = bh * 32 + c;
        const float g = ld_coherent(STAT + u * 4), ml = ld_coherent(STAT + u * 4 + 1);
        CPREV[(size_t)u * 4096 + idx] = (bf16_t)(pk2(Cst, 0.f) & 0xffffu);
        if (do_n) NPREV[u * 64 + F.tid] = nst;
        const float mnew = fmaxf(g + mst, ml), aa = expf(g + mst - mnew), bb = expf(ml - mnew);
        Cst = aa * Cst + bb * CLOC[(size_t)u * 4096 + idx];
        if (do_n) nst = aa * nst + bb * NLOC[u * 64 + F.tid];
        mst = mnew;
    }
}

__device__ __forceinline__ void mlstm_stage3_pair(const Args& a, const Frame& F, int it) {
    const int grp = F.wave >> 2, w4 = F.wave & 3, gt = w4 * 64 + F.lane, lane = F.lane, r32 = lane & 31, hh = lane >> 5;
    LAS unsigned char* gl = F.lds + grp * ML_GRP;
    LAS unsigned char* Qs = gl, * Ks = gl + ML_TILE, * Vt = gl + 2 * ML_TILE, * Cs = gl + 3 * ML_TILE; LAS float* vec = (LAS float*)(gl + 4 * ML_TILE);
    const int u = it * 2 + grp, c = u & 31, bh = u >> 5, b = bh >> 2, h = bh & 3;
    const float* STAT = (const float*)(a.ws + WS_STAT);
    __syncthreads();
    if (w4 == 0) {
        float bc, gi; ml_gates(a, lane, b, h, c, vec, bc, gi);
        const float igmb = gi - bc;
        vec[lane] = bc; vec[64 + lane] = igmb; LDS_WAIT(); asm volatile("" ::: "memory");
        float pm = -INFINITY;
        for (int s = 0; s < 64; ++s) { const float v = vec[64 + s]; pm = (s <= lane) ? fmaxf(pm, v) : pm; }
        float mprev = 0.f;
        for (int cc = 0; cc < c; ++cc) { const float g_ = ld_coherent(STAT + (u - c + cc) * 4), ml_ = ld_coherent(STAT + (u - c + cc) * 4 + 1); mprev = fmaxf(g_ + mprev, ml_); }
        const float il = bc + mprev, mj = fmaxf(il, bc + pm);
        vec[192 + lane] = mj; vec[256 + lane] = expf(il - mj);
    }
    if (w4 == 1) vec[320 + lane] = ((const float*)(a.ws + WS_NPREV))[u * 64 + lane];
    {
        const bf16_t* Z = (const bf16_t*)(a.ws + WS_Z) + ((size_t)b * S + c * 64) * ZLD;
        const bf16_t* VT = (const bf16_t*)(a.ws + WS_MVT) + (size_t)bh * 64 * S + c * 64;
        const bf16_t* CP = (const bf16_t*)(a.ws + WS_CPREV) + (size_t)u * 4096;
#pragma unroll
        for (int i = 0; i < 2; ++i) {
            const int p = gt + 256 * i, row = p >> 3, pc = p & 7;
            *(LAS u32x4*)(Qs + row * ML_STR + pc * 16) = *(const u32x4*)(Z + (size_t)row * ZLD + 512 + h * 64 + pc * 8);
            *(LAS u32x4*)(Ks + row * ML_STR + pc * 16) = *(const u32x4*)(Z + (size_t)row * ZLD + 768 + h * 64 + pc * 8);
            *(LAS u32x4*)(Vt + row * ML_STR + pc * 16) = *(const u32x4*)(VT + (size_t)row * S + pc * 8);
            *(LAS u32x4*)(Cs + row * ML_STR + pc * 16) = *(const u32x4*)(CP + row * 64 + pc * 8);
        }
    }
    __syncthreads();
    const int jb = w4 & 1, eb = w4 >> 1, j = jb * 32 + r32;
    const float mj = vec[192 + j], ainter = vec[256 + j], bj = vec[j] - mj;
    f32x16 p0, p1, X;
#pragma unroll
    for (int i = 0; i < 16; ++i) { p0[i] = 0.f; p1[i] = 0.f; X[i] = 0.f; }
    bf16x8 qf[4];
#pragma unroll
    for (int ks = 0; ks < 4; ++ks) qf[ks] = *(const LAS bf16x8*)(Qs + j * ML_STR + ks * 32 + hh * 16);
#pragma unroll
    for (int ks = 0; ks < 4; ++ks) {
        const bf16x8 k0 = *(const LAS bf16x8*)(Ks + r32 * ML_STR + ks * 32 + hh * 16), k1 = *(const LAS bf16x8*)(Ks + (32 + r32) * ML_STR + ks * 32 + hh * 16);
        const bf16x8 cf = *(const LAS bf16x8*)(Cs + (eb * 32 + r32) * ML_STR + ks * 32 + hh * 16);
        p0 = __builtin_amdgcn_mfma_f32_32x32x16_bf16(k0, qf[ks], p0, 0, 0, 0);
        p1 = __builtin_amdgcn_mfma_f32_32x32x16_bf16(k1, qf[ks], p1, 0, 0, 0);
        X = __builtin_amdgcn_mfma_f32_32x32x16_bf16(cf, qf[ks], X, 0, 0, 0);
    }
    float rs = 0.f;
#pragma unroll
    for (int r = 0; r < 16; ++r) {
        const int s0 = crow(r, hh), s1 = 32 + s0;
        const float w0 = (s0 <= j) ? expf(bj + vec[64 + s0]) * 0.125f : 0.f, w1 = (s1 <= j) ? expf(bj + vec[64 + s1]) * 0.125f : 0.f;
        p0[r] *= w0; p1[r] *= w1; rs += p0[r] + p1[r];
    }
    rs = xor32_sum(rs);
    float qn = 0.f;
#pragma unroll
    for (int pc = 0; pc < 4; ++pc) { const u32x4 qv = *(const LAS u32x4*)(Qs + j * ML_STR + (hh * 4 + pc) * 16); const LAS float* nv = vec + 320 + hh * 32 + pc * 8;
        qn += bflo(qv.x) * nv[0] + bfhi(qv.x) * nv[1] + bflo(qv.y) * nv[2] + bfhi(qv.y) * nv[3] + bflo(qv.z) * nv[4] + bfhi(qv.z) * nv[5] + bflo(qv.w) * nv[6] + bfhi(qv.w) * nv[7]; }
    qn = xor32_sum(qn);
#ifdef MK_EXP_NOINTER
    qn = 0.f;
#endif
    const float den = ainter * qn * 0.125f + rs;
    const float dinv = 1.0f / fmaxf(fabsf(den), expf(-mj));
    f32x16 Y;
#pragma unroll
    for (int i = 0; i < 16; ++i) Y[i] = 0.f;
#pragma unroll
    for (int kbk = 0; kbk < 2; ++kbk)
#pragma unroll
        for (int s2 = 0; s2 < 2; ++s2) {
            u32x4 pw;
            if (kbk == 0) { pw.x = pk2(p0[8 * s2], p0[8 * s2 + 1]); pw.y = pk2(p0[8 * s2 + 2], p0[8 * s2 + 3]); pw.z = pk2(p0[8 * s2 + 4], p0[8 * s2 + 5]); pw.w = pk2(p0[8 * s2 + 6], p0[8 * s2 + 7]); }
            else { pw.x = pk2(p1[8 * s2], p1[8 * s2 + 1]); pw.y = pk2(p1[8 * s2 + 2], p1[8 * s2 + 3]); pw.z = pk2(p1[8 * s2 + 4], p1[8 * s2 + 5]); pw.w = pk2(p1[8 * s2 + 6], p1[8 * s2 + 7]); }
            const bf16x8 af = *(const LAS bf16x8*)(Vt + (eb * 32 + r32) * ML_STR + (kbk * 32 + s2 * 16) * 2 + hh * 16);
            Y = __builtin_amdgcn_mfma_f32_32x32x16_bf16(af, __builtin_bit_cast(bf16x8, pw), Y, 0, 0, 0);
        }
    const size_t trow = (size_t)b * S + c * 64 + j;
    const bf16_t* orow = (const bf16_t*)(a.ws + WS_Z) + trow * ZLD + 1024 + h * 64 + eb * 32;
    bf16_t* yrow = (bf16_t*)(a.ws + WS_MIX) + trow * D + 256 + h * 64 + eb * 32;
#ifdef MK_EXP_NOINTER
    const float xs = 0.f;
#else
    const float xs = ainter * 0.125f;
#endif
#pragma unroll
    for (int g = 0; g < 4; ++g) {
        const u32x2 ov = *(const u32x2*)(orow + 8 * g + 4 * hh);
        const float o0 = sigmoidf_(bflo(ov.x)), o1 = sigmoidf_(bfhi(ov.x)), o2 = sigmoidf_(bflo(ov.y)), o3 = sigmoidf_(bfhi(ov.y));
        u32x2 w; w.x = pk2((xs * X[4 * g] + Y[4 * g]) * dinv * o0, (xs * X[4 * g + 1] + Y[4 * g + 1]) * dinv * o1);
        w.y = pk2((xs * X[4 * g + 2] + Y[4 * g + 2]) * dinv * o2, (xs * X[4 * g + 3] + Y[4 * g + 3]) * dinv * o3);
        *(u32x2*)(yrow + 8 * g + 4 * hh) = w;
    }
}

__device__ __forceinline__ void phase_ln1_router(const Args& args, const Frame& F0, int l, const float* xin_skel) {
    const Frame F = phase_frame(F0);
    float* PRE = (float*)(args.ws + WS_PRE); bf16_t* U = (bf16_t*)(args.ws + WS_U);
    int* LIST = (int*)(args.ws + WS_LIST); float* ROUTE = (float*)(args.ws + WS_ROUTE);
    const float* WR = args.in[I_WR]; const float* BR = args.in[I_BR];
    for (int m = F.gw; m < T; m += F.NGW) {
        f32x4 v[4];
        if (xin_skel) { const f32x4* xr = (const f32x4*)(xin_skel + (size_t)m * D) + F.lane;
#pragma unroll
            for (int j = 0; j < 4; ++j) v[j] = xr[64 * j] * DN_ALPHA; }
        else { const f32x4* xr = (const f32x4*)(PRE + (size_t)m * D) + F.lane;
#pragma unroll
            for (int j = 0; j < 4; ++j) v[j] = xr[64 * j]; }
        float mean, rstd; ln_stats(v, mean, rstd);
#pragma unroll
        for (int j = 0; j < 4; ++j) {
            const int c = 4 * F.lane + 256 * j;
            const f32x4 g = *(const f32x4*)(args.in[I_LN1G] + l * D + c), bb = *(const f32x4*)(args.in[I_LN1B] + l * D + c);
            v[j] = (v[j] - mean) * rstd * g + bb;
            *(f32x4*)(PRE + (size_t)m * D + c) = v[j];
        }
        ln_stats(v, mean, rstd);
        const int b = m >> 11;
        float lg[16];
#pragma unroll
        for (int e = 0; e < 16; ++e) lg[e] = 0.f;
#pragma unroll
        for (int j = 0; j < 4; ++j) {
            const int c = 4 * F.lane + 256 * j;
            const f32x4 sh = mod4(args, l, b, 3072 + c), sc = mod4(args, l, b, 4096 + c);
            const f32x4 u = (v[j] - mean) * rstd * (sc + 1.0f) + sh;
            u32x2 o; o.x = pk2(u.x, u.y); o.y = pk2(u.z, u.w);
            *(u32x2*)(U + (size_t)m * D + c) = o;
#pragma unroll
            for (int i = 0; i < 4; ++i) { const f32x4* w = (const f32x4*)(WR + (size_t)(c + i) * 16);
#pragma unroll
                for (int q = 0; q < 4; ++q) { const f32x4 wv = w[q]; lg[4 * q] += u[i] * wv.x; lg[4 * q + 1] += u[i] * wv.y; lg[4 * q + 2] += u[i] * wv.z; lg[4 * q + 3] += u[i] * wv.w; } }
        }
#pragma unroll
        for (int e = 0; e < 16; ++e) lg[e] = wave_sum(lg[e]);
        int e0, e1; float w0, w1; route_select(lg, BR, e0, e1, w0, w1);
        if (F.lane == 0) {
            ROUTE[m * 2] = w0; ROUTE[m * 2 + 1] = w1;
            const unsigned s0 = atomicAdd(F.ctl + CW_CNT + 64 * l + e0, 1u); LIST[e0 * T + s0] = m * 2;
            const unsigned s1 = atomicAdd(F.ctl + CW_CNT + 64 * l + e1, 1u); LIST[e1 * T + s1] = m * 2 + 1;
        }
    }
}
__device__ __forceinline__ void phase_ln2_final(const Args& args, const Frame& F0, int l, bool with_moe) {
    const Frame F = phase_frame(F0);
    const float* X1 = (const float*)(args.ws + WS_PRE); const bf16_t* YB = (const bf16_t*)(args.ws + WS_YB); bf16_t* U = (bf16_t*)(args.ws + WS_U);
    for (int m = F.gw; m < T; m += F.NGW) {
        const int b = m >> 11;
        f32x4 v[4];
#pragma unroll
        for (int j = 0; j < 4; ++j) {
            const int c = 4 * F.lane + 256 * j;
            v[j] = *(const f32x4*)(X1 + (size_t)m * D + c) * DN_ALPHA;
            if (with_moe) {
                const u32x2 y0 = *(const u32x2*)(YB + (size_t)(2 * m) * D + c), y1 = *(const u32x2*)(YB + (size_t)(2 * m + 1) * D + c);
                const f32x4 g2 = mod4(args, l, b, 5120 + c);
                const f32x4 y = (f32x4){bflo(y0.x) + bflo(y1.x), bfhi(y0.x) + bfhi(y1.x), bflo(y0.y) + bflo(y1.y), bfhi(y0.y) + bfhi(y1.y)};
                v[j] += g2 * y;
            }
        }
        float mean, rstd; ln_stats(v, mean, rstd);
#pragma unroll
        for (int j = 0; j < 4; ++j) {
            const int c = 4 * F.lane + 256 * j;
            const f32x4 g = *(const f32x4*)(args.in[I_LN2G] + l * D + c), bb = *(const f32x4*)(args.in[I_LN2B] + l * D + c);
            v[j] = (v[j] - mean) * rstd * g + bb;
            *(f32x4*)(args.out + (size_t)m * D + c) = v[j];
        }
        if (l + 1 < DEPTH) lnmod_row(args, F, l + 1, 0, v, b, U + (size_t)m * D);
    }
}

#define GRID_BAR() xcd_barrier(bar)
template <int l>
__device__ __forceinline__ void layer_body(const Frame& F, const XcdBarrier& bar, volatile LAS unsigned* MISC) {
#if MK_MIXER
        {
            const Args args = load_args();
            pg8::Gemm g{(const bf16_t*)(args.ws + WS_U), (const bf16_t*)(args.ws + WS_BTIN), D, D, nullptr};
            pg8::StaticOrder So; const Frame Fp = phase_frame(F); So.init(T, NIN, D, D, Fp.G, Fp.bid); EpiIn E{args.ws, args.in[I_BI], args.in[I_BF], l};
            pg8::gemm_phase<EpiIn, pg8::StaticOrder, false>(F.lds, Fp.wave, g, So, E);
        }
        GRID_BAR();
        {
            const Args args = load_args();
            pg8::Gemm g{(const bf16_t*)(args.ws + WS_Z), (const bf16_t*)(args.ws + WS_BTUP), ZLD, 384, nullptr};
            pg8::StaticOrder So; const Frame Fp = phase_frame(F); So.init(T, 1024, ZLD, 384, Fp.G, Fp.bid); EpiUp E{args.ws, l};
            pg8::gemm_phase<EpiUp, pg8::StaticOrder, false>(F.lds, Fp.wave, g, So, E);
        }
#if MK_MIXER >= 3
        { const Args args = load_args(); mlstm_stage1(args, F); }
#endif
        { const Args args = load_args(); conv_phase(args, F, l); }
        GRID_BAR();
        {
            const Args args = load_args(); const Frame Fp = phase_frame(F);
            for (;;) { const int it = queue_next(Fp, l * 4 + 0); if (it >= 512) break;
#if MK_MIXER >= 2
                if (it < 256) { mla_unit(args, Fp, it & 31, 7 - (it >> 5)); continue; }
#endif
#if MK_MIXER >= 3
                if (it >= 256) mlstm_scan_unit(args, Fp, it - 256);
#endif
            }
        }
        GRID_BAR();
        {
            const Args args = load_args(); const Frame Fp = phase_frame(F);
            for (;;) { const int it = queue_next(Fp, l * 4 + 1); if (it >= 768) break;
#if MK_MIXER >= 2
                if (it < 256) { diff_unit(args, Fp, l, it & 31, 7 - (it >> 5)); continue; }
#endif
#if MK_MIXER >= 3 && !defined(MK_EXP_NOSTAGE3)
                if (it >= 256) mlstm_stage3_pair(args, Fp, it - 256);
#endif
            }
        }
        GRID_BAR();
        {
            const Args args = load_args(); const float* xin = (l == 0) ? args.in[I_X] : args.out;
            pg8::Gemm g{(const bf16_t*)(args.ws + WS_MIX), (const bf16_t*)(args.ws + WS_BTOUT), D, D, nullptr};
            pg8::StaticOrder So; const Frame Fp = phase_frame(F); So.init(T, D, D, D, Fp.G, Fp.bid); EpiOut E{args.ws, args.in[I_BADA], xin, l};
            pg8::gemm_phase<EpiOut, pg8::StaticOrder, false>(F.lds, Fp.wave, g, So, E);
        }
        GRID_BAR();
#endif
        { const Args args = load_args(); const float* xin = (l == 0) ? args.in[I_X] : args.out;
          phase_ln1_router(args, F, l, MK_MIXER ? nullptr : xin); }
        GRID_BAR();
        moe_tile_table(F, l);
        {
            const Args args = load_args();
            pg8::Gemm g{(const bf16_t*)(args.ws + WS_U), (const bf16_t*)(args.ws + WS_BT13), D, D, (const int*)(args.ws + WS_LIST)};
            const Frame Fp = phase_frame(F); MoeOrder So{MISC, Fp.G, Fp.bid, 2, 1}; EpiMoe1 E{args.ws};
            pg8::gemm_phase<EpiMoe1, MoeOrder, true>(F.lds, Fp.wave, g, So, E);
        }
        GRID_BAR();
        {
            const Args args = load_args();
            pg8::Gemm g{(const bf16_t*)(args.ws + WS_H), (const bf16_t*)(args.ws + WS_BT2), DEXP, DEXP, nullptr};
            const Frame Fp = phase_frame(F); MoeOrder So{MISC, Fp.G, Fp.bid, 4, 2}; EpiMoe2 E{args.ws};
            pg8::gemm_phase<EpiMoe2, MoeOrder, false>(F.lds, Fp.wave, g, So, E);
        }
        GRID_BAR();
        { const Args args = load_args();
          phase_ln2_final(args, F, l, true);
          if (l + 1 < DEPTH) { __syncthreads(); convert_weights(args, F, l + 1); } }
        if (l + 1 < DEPTH) GRID_BAR();
}

__global__ void __launch_bounds__(NTHREADS, 2) mk_fwd(Args args_unused) {
    extern __shared__ __attribute__((aligned(16))) unsigned char lds_raw[];
    Frame F;
    F.lds = (LAS unsigned char*)lds_raw;
    { const Args a0 = load_args(); F.ws = a0.ws; F.ctl = (unsigned*)(a0.ws + WS_CTL); }
    F.wave = __builtin_amdgcn_readfirstlane((int)threadIdx.x >> 6); F.lane = lane_id(); F.tid = F.wave * 64 + F.lane;
    F.bid = blockIdx.x; F.G = gridDim.x; F.gw = F.bid * NWAVES + F.wave; F.NGW = F.G * NWAVES;
    volatile LAS unsigned* MISC = (volatile LAS unsigned*)(F.lds + LDS_MISC);
    for (int u = F.tid; u < (LDS_BYTES - LDS_MISC) / 4; u += NTHREADS) ((LAS unsigned*)(F.lds + LDS_MISC))[u] = 0u;
    __syncthreads();
    XcdBarrier bar = xcd_barrier_post(F.ctl + CW_BAR, MISC + 8, F.wave);

    { const Args args = load_args();
      convert_weights(args, F, 0);
      __syncthreads();
      mod_gemv(args, F);
      rope_table(args, F); }
    GRID_BAR();
    {
        const Args args = load_args(); const Frame Fp = phase_frame(F);
        bf16_t* U = (bf16_t*)(args.ws + WS_U);
        for (int m = Fp.gw; m < T; m += Fp.NGW) {
            const f32x4* xr = (const f32x4*)(args.in[I_X] + (size_t)m * D) + Fp.lane;
            f32x4 v[4];
#pragma unroll
            for (int j = 0; j < 4; ++j) v[j] = xr[64 * j];
            lnmod_row(args, Fp, 0, 0, v, m >> 11, U + (size_t)m * D);
        }
    }
    GRID_BAR();

    layer_body<0>(F, bar, MISC);
    layer_body<1>(F, bar, MISC);
}

extern "C" void kernel_launch(void* const* d_in, const int* in_sizes, int n_in, void* d_out, int out_size, void* d_ws, size_t ws_size, hipStream_t stream) {
    static int grid = 0;
    if (grid == 0) {
        if (n_in != 27 || out_size != T * D || ws_size < WS_END) { fprintf(stderr, "kernel_launch: unexpected problem (n_in %d out %d ws %zu)\n", n_in, out_size, ws_size); grid = -1; return; }
        int dev = 0, cus = 0, per_cu = 0;
        if (hipGetDevice(&dev) != hipSuccess || hipDeviceGetAttribute(&cus, hipDeviceAttributeMultiprocessorCount, dev) != hipSuccess) { grid = -1; return; }
        if (hipFuncSetAttribute((const void*)mk_fwd, hipFuncAttributeMaxDynamicSharedMemorySize, LDS_BYTES) != hipSuccess) { fprintf(stderr, "kernel_launch: hipFuncSetAttribute failed\n"); grid = -1; return; }
        if (hipOccupancyMaxActiveBlocksPerMultiprocessor(&per_cu, (const void*)mk_fwd, NTHREADS, LDS_BYTES) != hipSuccess || per_cu < 1)
            fprintf(stderr, "kernel_launch: occupancy query reports %d per CU\n", per_cu);
        (void)hipGetLastError();
        grid = cus;
    }
    if (grid < 0) return;
    (void)hipMemsetAsync((char*)d_ws + WS_CTL, 0, CTL_ZERO_BYTES, stream);
    Args a{};
    for (int i = 0; i < 27; ++i) a.in[i] = (const float*)d_in[i];
    a.out = (float*)d_out; a.ws = (unsigned char*)d_ws;
    hipLaunchKernelGGL(mk_fwd, dim3(grid), dim3(NTHREADS), LDS_BYTES, stream, a);
}
```

```cpp
#include <hip/hip_runtime.h>
#include <cstdio>
#include <cstdint>

#define GAS __attribute__((address_space(1)))
#define LAS __attribute__((address_space(3)))
typedef unsigned short bf16_t;
typedef short bf16x8 __attribute__((ext_vector_type(8)));
typedef short s16x4 __attribute__((ext_vector_type(4)));
typedef float f32x2 __attribute__((ext_vector_type(2)));
typedef float f32x4 __attribute__((ext_vector_type(4)));
typedef float f32x16 __attribute__((ext_vector_type(16)));
typedef unsigned u32x2 __attribute__((ext_vector_type(2)));
typedef unsigned u32x4 __attribute__((ext_vector_type(4)));
typedef __bf16 bf16x2_t __attribute__((ext_vector_type(2)));

#ifndef MK_STAMP
#define MK_STAMP (-1)
#endif
#ifndef MK_PROBE_PHASE
#define MK_PROBE_PHASE (-1)
#endif
#ifndef MK_PROBE_KIND
#define MK_PROBE_KIND 0
#endif
#ifndef MK_PROBE_N
#define MK_PROBE_N 1
#endif
#define REPS(k) for (int rep_ = 0; rep_ < ((MK_PROBE_PHASE == (k)) ? MK_PROBE_N + 1 : 1); ++rep_)
#ifndef MK_MIXER
#define MK_MIXER 3
#endif
constexpr int NB = 8, S = 2048, D = 1024, T = NB * S, DEPTH = 2;
constexpr int NWAVES = 8, NTHREADS = NWAVES * 64;
constexpr int NIN = 3072;
constexpr int ZLD = 2048;
constexpr int WIN_COLS = 2920;
constexpr int NEXP = 16, DEXP = 256;
constexpr float LN_EPS = 1e-5f, RMS_EPS = 1e-6f;
constexpr float DN_ALPHA = 1.4142135623730951f;
constexpr float LOG2E = 1.4426950408889634f;

constexpr size_t MiB = 1u << 20;
constexpr size_t WS_CTL = 0, CTL_ZERO_BYTES = 1 * MiB;
constexpr int CW_BAR = 4096;
constexpr int CW_Q = 8192;
constexpr int CW_ML = 131072;
constexpr int CW_MOE = 147456;
constexpr int CW_CQ = 200704;
constexpr int CW_MQ = 196608;
constexpr int CW_STAMP = 139264;
constexpr int CW_CNT = 12288;
constexpr size_t CTL_MOD = 64 * 1024;
constexpr size_t WS_BTIN = 2 * MiB, WS_BTUP = 8 * MiB, WS_BTOUT = 9 * MiB, WS_BT13 = 11 * MiB, WS_BT2 = 27 * MiB;
constexpr size_t WS_U = 35 * MiB;
constexpr size_t WS_CLOC = 35 * MiB, WS_CPREV = 51 * MiB, WS_NLOC = 59 * MiB, WS_NPREV = 59 * MiB + 512 * 1024, WS_STAT = 60 * MiB, WS_GV = 60 * MiB + 64 * 1024;
constexpr size_t WS_MIX = 67 * MiB, WS_H = 67 * MiB;
constexpr size_t WS_Z = 99 * MiB, WS_PRE = 99 * MiB;
constexpr size_t WS_QM = 163 * MiB, WS_KM = 175 * MiB, WS_VTM = 187 * MiB, WS_QD = 195 * MiB, WS_KD = 203 * MiB, WS_DVT = 211 * MiB, WS_MKT = 219 * MiB, WS_MVT = 227 * MiB;
constexpr size_t WS_YB = 163 * MiB;
constexpr size_t WS_ROPE = 235 * MiB, WS_GATES = 235 * MiB + 512 * 1024, WS_ROUTE = 236 * MiB, WS_LIST = 237 * MiB;
constexpr size_t WS_RSP = 238 * MiB;
constexpr size_t WS_BT13B = 239 * MiB;
constexpr size_t WS_END = 255 * MiB;

constexpr int LDS_BYTES = 147456;
constexpr int LDS_MISC = 139264;

__device__ __forceinline__ unsigned pk2(float lo, float hi) { f32x2 v = {lo, hi}; bf16x2_t b = __builtin_convertvector(v, bf16x2_t); return __builtin_bit_cast(unsigned, b); }
__device__ __forceinline__ void st_bf16x4(bf16_t* p, f32x4 v) { u32x2 o; o.x = pk2(v.x, v.y); o.y = pk2(v.z, v.w); *(u32x2*)p = o; }
__device__ __forceinline__ float bf2f(unsigned short u) { return __uint_as_float(((unsigned)u) << 16); }
__device__ __forceinline__ float bflo(unsigned w) { return __uint_as_float(w << 16); }
__device__ __forceinline__ float bfhi(unsigned w) { return __uint_as_float(w & 0xffff0000u); }
template <int M> __device__ __forceinline__ float swz_xor(float v) { return __int_as_float(__builtin_amdgcn_ds_swizzle(__float_as_int(v), (M << 10) | 0x1f)); }
__device__ __forceinline__ void xor32_pair(float v, float& lo, float& hi) { auto rr = __builtin_amdgcn_permlane32_swap(__float_as_uint(v), __float_as_uint(v), false, false); lo = __uint_as_float(rr[0]); hi = __uint_as_float(rr[1]); }
__device__ __forceinline__ float xor32_sum(float v) { float a, b; xor32_pair(v, a, b); return a + b; }
__device__ __forceinline__ float xor32_max(float v) { float a, b; xor32_pair(v, a, b); return fmaxf(a, b); }
template <int CTRL> __device__ __forceinline__ float dppx(float v) { return __int_as_float(__builtin_amdgcn_update_dpp(0, __float_as_int(v), CTRL, 0xf, 0xf, true)); }
__device__ __forceinline__ void xor16_pair(float v, float& lo, float& hi) { auto rr = __builtin_amdgcn_permlane16_swap(__float_as_uint(v), __float_as_uint(v), false, false); lo = __uint_as_float(rr[0]); hi = __uint_as_float(rr[1]); }
__device__ __forceinline__ float xor16_sum(float v) { float a, b; xor16_pair(v, a, b); return a + b; }
__device__ __forceinline__ float wave_sum(float v) {
    v += dppx<0xB1>(v); v += dppx<0x4E>(v); v += dppx<0x141>(v); v += dppx<0x140>(v);
    v = xor16_sum(v); return xor32_sum(v);
}
__device__ __forceinline__ float wave_max(float v) {
    v = fmaxf(v, dppx<0xB1>(v)); v = fmaxf(v, dppx<0x4E>(v)); v = fmaxf(v, dppx<0x141>(v)); v = fmaxf(v, dppx<0x140>(v));
    { float a, b; xor16_pair(v, a, b); v = fmaxf(a, b); } return xor32_max(v);
}
__device__ __forceinline__ float ld_coherent(const float* p) { return __hip_atomic_load(p, __ATOMIC_RELAXED, __HIP_MEMORY_SCOPE_AGENT); }
__device__ __forceinline__ float sigmoidf_(float x) { return __builtin_amdgcn_rcpf(1.0f + __expf(-x)); }
__device__ __forceinline__ float siluf_(float x) { return x / (1.0f + __expf(-x)); }
__device__ __forceinline__ int lane_id();
#define LAUNDER(x) asm volatile("" : "+v"(x))
#define LAUNDER_S(x) asm volatile("" : "+s"(x))
__device__ __forceinline__ f32x4 ld_bf16x4(const bf16_t* p) { const u32x2 w = *(const u32x2*)p; return (f32x4){__uint_as_float(w.x << 16), __uint_as_float(w.x & 0xffff0000u), __uint_as_float(w.y << 16), __uint_as_float(w.y & 0xffff0000u)}; }
#define LDS_WAIT() asm volatile("s_waitcnt lgkmcnt(0)" ::: "memory")
#define VM_WAIT() asm volatile("s_waitcnt vmcnt(0)" ::: "memory")

#define XB_TMO      128
#define XB_XCNT(j)  (256  + 64 * (j))
#define XB_XSUB(j)  (1280 + 64 * (j))
#define XB_XGEN(j)  (2304 + 64 * (j))
#define XB_TOP      3328
#define XB_TOPGEN   3392
#define XCD_BAR_WORDS 3456
#define XB_SPIN_CAP (1u << 22)
__device__ __forceinline__ unsigned xb_ld(unsigned* p)              { return __hip_atomic_load(p, __ATOMIC_RELAXED, __HIP_MEMORY_SCOPE_AGENT); }
__device__ __forceinline__ unsigned xb_add(unsigned* p, unsigned v) { return __hip_atomic_fetch_add(p, v, __ATOMIC_RELAXED, __HIP_MEMORY_SCOPE_AGENT); }
__device__ __forceinline__ unsigned xb_xcc_id() { return (unsigned)__builtin_amdgcn_s_getreg((3 << 11) | 20) & 0xFu; }
#define XB_SPIN(cond, bar) do { unsigned _sp = 0; while (cond) { __builtin_amdgcn_s_sleep(1); \
    if ((++_sp & 255u) == 0u) { if (xb_ld(&(bar)[XB_TMO])) break; if (_sp > XB_SPIN_CAP) { atomicAdd(&(bar)[XB_TMO], 1u); break; } } } } while (0)
struct XcdBarrier { unsigned* bar; unsigned x; volatile LAS unsigned* st; int wave; };
__device__ __forceinline__ int lane_id_() { int l; asm volatile("v_mbcnt_lo_u32_b32 %0, -1, 0\n\tv_mbcnt_hi_u32_b32 %0, -1, %0" : "=v"(l)); return l; }
__device__ __forceinline__ XcdBarrier xcd_barrier_post(unsigned* bar, volatile LAS unsigned* st, int wave) {
    XcdBarrier b; b.bar = bar; b.x = xb_xcc_id(); b.st = st; b.wave = wave;
    if (wave == 0 && lane_id_() == 0) (void)xb_add(&bar[XB_XCNT(b.x)], 1u);
    return b;
}
__device__ __forceinline__ void xcd_barrier_complete(unsigned* bar, unsigned x, unsigned& nloc, unsigned& nx) {
    const unsigned G = gridDim.x * gridDim.y * gridDim.z;
    unsigned sum, cnt, mine, sp = 0u;
    for (;;) {
        sum = 0u; cnt = 0u; mine = 0u;
#pragma unroll
        for (unsigned j = 0; j < 16; ++j) { const unsigned c = xb_ld(&bar[XB_XCNT(j)]); sum += c; cnt += (c > 0u) ? 1u : 0u; mine = (j == x) ? c : mine; }
        if (sum == G) break;
        __builtin_amdgcn_s_sleep(1);
        if ((++sp & 255u) == 0u) { if (xb_ld(&bar[XB_TMO])) break; if (sp > XB_SPIN_CAP) { atomicAdd(&bar[XB_TMO], 1u); break; } }
    }
    nloc = mine > 0u ? mine : 1u; nx = cnt > 0u ? cnt : 1u;
}
__device__ __forceinline__ void xcd_barrier(const XcdBarrier& b) {
    asm volatile("s_waitcnt vmcnt(0)" ::: "memory");
    __syncthreads();
    if (b.wave == 0 && lane_id_() == 0) {
        unsigned* bar = b.bar; asm volatile("" : "+s"(bar));
        __builtin_amdgcn_s_waitcnt(0);
        unsigned nloc = b.st[0], nx = b.st[1];
        unsigned bx = b.x; asm volatile("" : "+s"(bx));
        if (nloc == 0u) { xcd_barrier_complete(bar, bx, nloc, nx); b.st[0] = nloc; b.st[1] = nx; }
        const unsigned old = xb_add(&bar[XB_XSUB(bx)], 1u);
        const unsigned gen = old / nloc;
        if (old + 1u == (gen + 1u) * nloc) {
            __builtin_amdgcn_fence(__ATOMIC_RELEASE, "agent");
            asm volatile("s_waitcnt vmcnt(0)" ::: "memory");
            const unsigned og = xb_add(&bar[XB_TOP], 1u);
            const unsigned tg = og / nx;
            if (og + 1u == (tg + 1u) * nx) xb_add(&bar[XB_TOPGEN], 1u);
            else XB_SPIN(xb_ld(&bar[XB_TOPGEN]) == tg, bar);
            __builtin_amdgcn_fence(__ATOMIC_ACQUIRE, "agent");
            xb_add(&bar[XB_XGEN(bx)], 1u);
            asm volatile("s_waitcnt vmcnt(0)" ::: "memory");
        } else {
            XB_SPIN(xb_ld(&bar[XB_XGEN(bx)]) == gen, bar);
            __builtin_amdgcn_fence(__ATOMIC_ACQUIRE, "agent");
            asm volatile("s_waitcnt vmcnt(0)" ::: "memory");
        }
    }
    __syncthreads();
}

struct Args { const float* in[27]; float* out; unsigned char* ws; int pad0, pad1; };
enum { I_X = 0, I_C, I_WADA, I_BADA, I_WIN, I_GQ, I_GKV, I_WUQ, I_WUKV, I_BI, I_BF, I_SCW, I_LQ1, I_LK1, I_LQ2, I_LK2, I_DFG, I_WOUT, I_LN1G, I_LN1B,
       I_WR, I_BR, I_W1, I_W3, I_W2, I_LN2G, I_LN2B };

struct Frame {
    LAS unsigned char* lds;
    unsigned char* ws;
    unsigned* ctl;
    int tid, lane, wave, bid, G, gw, NGW;
};

__device__ __forceinline__ int lane_id() { return lane_id_(); }
__device__ __forceinline__ Args load_args() {
    typedef const volatile __attribute__((address_space(4))) unsigned long long* kptr_t;
    kptr_t p = (kptr_t)__builtin_amdgcn_kernarg_segment_ptr();
    Args a;
#pragma unroll
    for (int i = 0; i < 27; ++i) a.in[i] = (const float*)(const GAS float*)p[i];
    a.out = (float*)(GAS float*)p[27]; a.ws = (unsigned char*)(GAS unsigned char*)p[28]; a.pad0 = 0; a.pad1 = 0;
    return a;
}
__device__ __forceinline__ Frame phase_frame(const Frame& F0) { Frame F = F0; LAUNDER_S(F.wave); LAUNDER_S(F.bid); LAUNDER_S(F.G); F.gw = F.bid * NWAVES + F.wave; F.NGW = F.G * NWAVES; F.lane = lane_id(); LAUNDER(F.lane); F.tid = F.wave * 64 + F.lane; return F; }

__device__ __forceinline__ f32x4 mod4p(const unsigned char* ws, const float* bada, int l, int b, int idx) {
    const float* M = (const float*)(ws + CTL_MOD) + (size_t)(l * 8 + b) * 6144 + idx;
    const float* Bv = bada + (size_t)l * 6144 + idx;
    return *(const f32x4*)M + *(const f32x4*)Bv;
}
__device__ __forceinline__ f32x4 mod4(const Args& a, int l, int b, int idx) { return mod4p(a.ws, a.in[I_BADA], l, b, idx); }

__device__ __forceinline__ void ln_stats(const f32x4 (&v)[4], float& mean, float& rstd) {
    float s = 0.f;
#pragma unroll
    for (int j = 0; j < 4; ++j) s += (v[j].x + v[j].y) + (v[j].z + v[j].w);
    mean = wave_sum(s) * (1.f / D);
    float s2 = 0.f;
#pragma unroll
    for (int j = 0; j < 4; ++j) { const f32x4 d = v[j] - mean; s2 += (d.x * d.x + d.y * d.y) + (d.z * d.z + d.w * d.w); }
    rstd = __builtin_amdgcn_rsqf(wave_sum(s2) * (1.f / D) + LN_EPS);
}

__device__ __forceinline__ void lnmod_row(const Args& a, const Frame& F, int l, int which  , const f32x4 (&v)[4], int b, bf16_t* urow) {
    float mean, rstd; ln_stats(v, mean, rstd);
#pragma unroll
    for (int j = 0; j < 4; ++j) {
        const int c = 4 * F.lane + 256 * j;
        const f32x4 sh = mod4(a, l, b, which * 3072 + c), sc = mod4(a, l, b, which * 3072 + 1024 + c);
        const f32x4 xn = (v[j] - mean) * rstd;
        const f32x4 u = xn * (sc + 1.0f) + sh;
        u32x2 o; o.x = pk2(u.x, u.y); o.y = pk2(u.z, u.w);
        *(u32x2*)(urow + c) = o;
    }
}

template <class SrcF>
__device__ __forceinline__ void transpose_item(const SrcF& src, bf16_t* dst, int Kd, int k0, int n0, LAS float* scr, int lane) {
    const int nl = 4 * (lane & 15), kl = lane >> 4;
    f32x4 v[16];
#pragma unroll
    for (int i = 0; i < 16; ++i) v[i] = src(k0 + 4 * i + kl, n0 + nl);
#pragma unroll
    for (int i = 0; i < 16; ++i) { LAS float* p = scr + (4 * i + kl) * 65 + nl; p[0] = v[i].x; p[1] = v[i].y; p[2] = v[i].z; p[3] = v[i].w; }
    LDS_WAIT(); asm volatile("" ::: "memory");
    const int c = lane & 7;
#pragma unroll
    for (int j = 0; j < 8; ++j) { const int n = (lane >> 3) + 8 * j; const LAS float* s = scr + (8 * c) * 65 + n;
        u32x4 o; o.x = pk2(s[0 * 65], s[1 * 65]); o.y = pk2(s[2 * 65], s[3 * 65]); o.z = pk2(s[4 * 65], s[5 * 65]); o.w = pk2(s[6 * 65], s[7 * 65]);
        *(u32x4*)(dst + (size_t)(n0 + n) * Kd + k0 + 8 * c) = o; }
    LDS_WAIT(); asm volatile("" ::: "memory");
}

__device__ __forceinline__ int zsrc_col(int n) {
    if (n < 352) return n;
    if (n < 360) return 1120 + (n - 352);
    if (n < 512) return -1;
    if (n < 768) return 352 + (n - 512);
    if (n < 1024) return 608 + (n - 768);
    if (n < 1280) return 864 + (n - 1024);
    if (n < 1536) return 1128 + (n - 1280);
    if (n < 1792) return 1384 + (n - 1536);
    if (n < 2048) return 1640 + (n - 1792);
    if (n < 2304) return 1896 + (n - 2048);
    if (n < 2560) return 2152 + (n - 2304);
    if (n < 2816) return 2408 + (n - 2560);
    return 2664 + (n - 2816);
}
constexpr f32x4 F4ZERO = {0.f, 0.f, 0.f, 0.f};
struct SrcIn { const float* W; __device__ __forceinline__ f32x4 operator()(int k, int n) const { const int c = zsrc_col(n); return c >= 0 ? *(const f32x4*)(W + (size_t)k * WIN_COLS + c) : F4ZERO; } };
struct SrcUp { const float* Wq; const float* Wkv; const float* gq; const float* gkv;
    __device__ __forceinline__ f32x4 operator()(int k, int n) const {
        if (n < 384) { if (k >= 192) return F4ZERO; const int col = (n < 256) ? ((n >> 6) * 96 + (n & 63)) : (((n - 256) >> 5) * 96 + 64 + ((n - 256) & 31)); return *(const f32x4*)(Wq + (size_t)k * 384 + col) * gq[k]; }
        if (n < 512) return F4ZERO;
        if (k < 192 || k >= 320) return F4ZERO;
        const int kk = k - 192; const int m = n - 512; const int col = (m < 256) ? ((m >> 6) * 128 + (m & 63)) : (((m - 256) >> 6) * 128 + 64 + ((m - 256) & 63));
        return *(const f32x4*)(Wkv + (size_t)kk * 512 + col) * gkv[kk];
    } };
struct SrcPlain { const float* W; int N; __device__ __forceinline__ f32x4 operator()(int k, int n) const { return *(const f32x4*)(W + (size_t)k * N + n); } };
struct Src13 { const float* W1; const float* W3;
    __device__ __forceinline__ f32x4 operator()(int k, int j) const { const int t = j >> 8, w = j & 255; return (w < 128) ? *(const f32x4*)(W1 + (size_t)k * 256 + t * 128 + w) : *(const f32x4*)(W3 + (size_t)k * 256 + t * 128 + (w - 128)); } };

__device__ __forceinline__ void convert_weights(const Args& a, const Frame& F0, int l, int which) {
    const Frame F = phase_frame(F0);
    LAS float* scr = (LAS float*)(F.lds + F.wave * 16896);
    constexpr int I_IN = (1024 / 64) * (NIN / 64);
    constexpr int I_UP = (384 / 64) * (1024 / 64);
    constexpr int I_OUT = (1024 / 64) * (1024 / 64);
    constexpr int I_13 = NEXP * (1024 / 64) * (512 / 64);
    constexpr int I_2 = NEXP * (256 / 64) * (1024 / 64);
    constexpr int NITEMS = I_IN + I_UP + I_OUT + I_13 + I_2;
    bf16_t* BtIn = (bf16_t*)(a.ws + WS_BTIN); bf16_t* BtUp = (bf16_t*)(a.ws + WS_BTUP); bf16_t* BtOut = (bf16_t*)(a.ws + WS_BTOUT);
    bf16_t* Bt13 = (bf16_t*)(a.ws + ((l & 1) ? WS_BT13B : WS_BT13)); bf16_t* Bt2 = (bf16_t*)(a.ws + WS_BT2);
    const int ibeg = (which == 2) ? NITEMS - I_2 : 0, iend = (which == 1) ? NITEMS - I_2 : NITEMS;
    volatile LAS int* cslot = (volatile LAS int*)(F.lds + LDS_MISC + 64);
    int chunk = 0;
    for (int it = ibeg + F.gw;; ) {
        if (which == 1) {
            __syncthreads(); if (F.tid == 0) *cslot = (int)__hip_atomic_fetch_add(F.ctl + CW_CQ, 1u, __ATOMIC_RELAXED, __HIP_MEMORY_SCOPE_AGENT); __syncthreads(); chunk = __builtin_amdgcn_readfirstlane(*cslot);
            if (chunk * 8 >= iend) break;
            it = chunk * 8 + F.wave;
            if (it >= iend) continue;
        } else if (it >= iend) break;
        int r = it; if (which != 1) it += F.NGW;
        if (r < I_IN) { const int nblk = NIN / 64; SrcIn s{a.in[I_WIN] + (size_t)l * 1024 * WIN_COLS}; transpose_item(s, BtIn, 1024, 64 * (r / nblk), 64 * (r % nblk), scr, F.lane); continue; } r -= I_IN;
        if (r < I_UP) { const int nblk = 1024 / 64; SrcUp s{a.in[I_WUQ] + (size_t)l * 192 * 384, a.in[I_WUKV] + (size_t)l * 128 * 512, a.in[I_GQ] + l * 192, a.in[I_GKV] + l * 128};
            transpose_item(s, BtUp, 384, 64 * (r / nblk), 64 * (r % nblk), scr, F.lane); continue; } r -= I_UP;
        if (r < I_OUT) { const int nblk = 1024 / 64; SrcPlain s{a.in[I_WOUT] + (size_t)l * 1024 * 1024, 1024}; transpose_item(s, BtOut, 1024, 64 * (r / nblk), 64 * (r % nblk), scr, F.lane); continue; } r -= I_OUT;
        if (r < I_13) { const int per = (1024 / 64) * (512 / 64); const int e = r / per, q = r % per; const int nblk = 512 / 64;
            Src13 s{a.in[I_W1] + ((size_t)l * NEXP + e) * 1024 * 256, a.in[I_W3] + ((size_t)l * NEXP + e) * 1024 * 256};
            transpose_item(s, Bt13 + (size_t)e * 512 * 1024, 1024, 64 * (q / nblk), 64 * (q % nblk), scr, F.lane); continue; } r -= I_13;
        { const int per = (256 / 64) * (1024 / 64); const int e = r / per, q = r % per; const int nblk = 1024 / 64;
            SrcPlain s{a.in[I_W2] + ((size_t)l * NEXP + e) * 256 * 1024, 1024};
            transpose_item(s, Bt2 + (size_t)e * 1024 * 256, 256, 64 * (q / nblk), 64 * (q % nblk), scr, F.lane); }
    }
}

__device__ __forceinline__ void mod_gemv(const Args& a, const Frame& F0) {
    const Frame F = phase_frame(F0);
    LAS float* sl = (LAS float*)F.lds;
    LAS float* red = (LAS float*)(F.lds + 32768);
    float* MOD = (float*)(a.ws + CTL_MOD);
    __syncthreads();
    for (int i = F.tid; i < 8 * 1024; i += NTHREADS) sl[i] = siluf_(a.in[I_C][i]);
    __syncthreads();
    const int col = F.tid & 63, kg = F.tid >> 6;
    for (int u = F.bid; u < 192; u += F.G) {
        const int l = u / 96, n = (u % 96) * 64 + col;
        float acc[8];
#pragma unroll
        for (int b = 0; b < 8; ++b) acc[b] = 0.f;
        const float* W = a.in[I_WADA] + ((size_t)l * 1024 + kg * 128) * 6144 + n;
#pragma unroll 16
        for (int kk = 0; kk < 128; ++kk) { const float w = W[(size_t)kk * 6144];
#pragma unroll
            for (int b = 0; b < 8; ++b) acc[b] += sl[b * 1024 + kg * 128 + kk] * w; }
#pragma unroll
        for (int b = 0; b < 8; ++b) red[(kg * 8 + b) * 64 + col] = acc[b];
        __syncthreads();
        { const int b = F.tid >> 6; float s = 0.f;
#pragma unroll
          for (int g = 0; g < 8; ++g) s += red[(g * 8 + b) * 64 + col];
          MOD[(size_t)(l * 8 + b) * 6144 + n] = s; }
        __syncthreads();
    }
}

__device__ __forceinline__ void rope_table(const Args& a, const Frame& F0) {
    const Frame F = phase_frame(F0);
    f32x2* R = (f32x2*)(a.ws + WS_ROPE);
    for (int i = F.bid * NTHREADS + F.tid; i < S * 16; i += F.G * NTHREADS) {
        const int s = i >> 4, f = i & 15;
        const float inv = 1.0f / powf(10000.0f, (float)(2 * f) / 32.0f);
        const float ang = (float)s * inv;
        R[i] = (f32x2){(float)cos((double)ang), (float)sin((double)ang)};
    }
}


namespace pg8 {
constexpr int BM = 256, BK = 64, HALF = 128, HTB = HALF * BK * 2, NXCD = 8, WGM = 8;
__host__ __device__ __forceinline__ int lds_byte(int r, int c) { const int st = (r >> 4) * 2 + (c >> 5), rr = r & 15, cc = c & 31, ob = rr * 64 + cc * 2; return st * 1024 + (ob ^ (((ob >> 9) & 1) << 5)); }
__host__ __device__ __forceinline__ int perm32(int rho) { const int n = rho >> 4, i = rho & 15; return 8 * (i >> 2) + 4 * n + (i & 3); }
__host__ __device__ __forceinline__ void stage_rc(int b, int& R, int& C) { const int st = b / 1024, sb = b % 1024, swz = sb ^ (((sb >> 9) & 1) << 5); R = (st >> 1) * 16 + swz / 64; C = (st & 1) * 32 + (swz % 64) / 2; }

struct Unit { int pm, pn; long aoff, boff; int x0, x1; };
struct Gemm { const bf16_t* A; const bf16_t* Bt; int lda; int K; const int* rows; };

struct StaticOrder {
    int nM, nN, nwg, G, c; int lda, K;
    __device__ __forceinline__ void a_ready(const Unit&, int, int) const {}
    __device__ void init(int M, int N, int lda_, int K_, int G_, int c_) { nM = M / BM; nN = N / BM; nwg = nM * nN; G = G_; c = c_; lda = lda_; K = K_; }
    __device__ bool next(int i, Unit& u) const {
        const long L = (long)i * G + c; if (L >= nwg) return false;
        int wgid = (int)L; { const int q = nwg / NXCD, r = nwg % NXCD, xcd = wgid % NXCD, off = wgid / NXCD; wgid = (xcd < r ? xcd * (q + 1) : r * (q + 1) + (xcd - r) * q) + off; }
        const int nig = WGM * nN, gid = wgid / nig, fm = gid * WGM, gsz = (nM - fm) < WGM ? (nM - fm) : WGM;
        u.pm = fm + ((wgid % nig) % gsz); u.pn = (wgid % nig) / gsz;
        u.aoff = (long)u.pm * BM * lda; u.boff = (long)u.pn * BM * K; u.x0 = 0; u.x1 = 0; return true;
    }
};

template <class Epi, class Sched, bool GATHER>
__device__ __forceinline__ void gemm_phase(LAS unsigned char* lds, int wave_idx, const Gemm g, const Sched& S, const Epi& E) {
    int lane = lane_id(); LAUNDER(lane);
    int wid = wave_idx; LAUNDER_S(wid); const int tid = wid * 64 + lane;
    const int wr = wid >> 2, wc = wid & 3, fr = lane & 15, fq = lane >> 4;
    int K = g.K; LAUNDER_S(K); const int nt = K / BK;
    unsigned voffB[2];
#pragma unroll
    for (int i = 0; i < 2; ++i) { int R_, C_; stage_rc(tid * 16 + i * 8192, R_, C_); if (Epi::PERM) R_ = (R_ & ~31) + perm32(R_ & 31); voffB[i] = (unsigned)(R_ * K + C_) * 2u; }
    unsigned vA[2][2];
    const size_t kstep = (size_t)(BK * 2);
    const size_t hstepB = (size_t)HALF * K * 2;
    const unsigned ldsw = (unsigned)wid * 1024u;
    const int aoff = lds_byte(wr * 64 + fr, fq * 8), boff = lds_byte(wc * 32 + fr, fq * 8);
#define PG8_SA(b, h) (((b) * 2 + (h)) * HTB)
#define PG8_SB(b, h) ((4 + (b) * 2 + (h)) * HTB)
#define PG8_STAGE_B(bufoff, gbase) do { _Pragma("unroll") for (int _i = 0; _i < 2; ++_i) \
        __builtin_amdgcn_global_load_lds((const unsigned*)((const char*)(gbase) + voffB[_i]), (LAS unsigned*)(lds + (bufoff) + ldsw + _i * 8192), 16, 0, 0); } while (0)
#define PG8_STAGE_A(bufoff, gbase, vo, h) do { _Pragma("unroll") for (int _i = 0; _i < 2; ++_i) \
        __builtin_amdgcn_global_load_lds((const unsigned*)((const char*)(gbase) + (vo)[h][_i]), (LAS unsigned*)(lds + (bufoff) + ldsw + _i * 8192), 16, 0, 0); } while (0)
#define PG8_LDA(dst, b, h) do { _Pragma("unroll") for (int m = 0; m < 4; ++m) _Pragma("unroll") for (int k = 0; k < 2; ++k) dst[m][k] = *(const LAS bf16x8*)(lds + PG8_SA(b, h) + aoff + m * 2048 + k * 1024); } while (0)
#define PG8_LDB(dst, b, h) do { _Pragma("unroll") for (int n = 0; n < 2; ++n) _Pragma("unroll") for (int k = 0; k < 2; ++k) dst[n][k] = *(const LAS bf16x8*)(lds + PG8_SB(b, h) + boff + n * 2048 + k * 1024); } while (0)
#define PG8_MMA(ai, bj, At, Bt) do { __builtin_amdgcn_s_setprio(1); _Pragma("unroll") for (int m = 0; m < 4; ++m) _Pragma("unroll") for (int n = 0; n < 2; ++n) _Pragma("unroll") for (int k = 0; k < 2; ++k) \
        acc[ai][bj][m][n] = __builtin_amdgcn_mfma_f32_16x16x32_bf16(Bt[n][k], At[m][k], acc[ai][bj][m][n], 0, 0, 0); __builtin_amdgcn_s_setprio(0); } while (0)
#define PG8_WAIT_V(n) asm volatile("s_waitcnt vmcnt(" #n ")" ::: "memory")
#define PG8_WAIT_L(n) asm volatile("s_waitcnt lgkmcnt(" #n ")" ::: "memory")
#define PG8_BAR __builtin_amdgcn_s_barrier()
#define PG8_SCHED __builtin_amdgcn_sched_barrier(0)
#define PG8_AOFFS(dst, u) do { _Pragma("unroll") for (int _h = 0; _h < 2; ++_h) _Pragma("unroll") for (int _i = 0; _i < 2; ++_i) { int _R, _C; stage_rc(tid * 16 + _i * 8192, _R, _C); \
        if (GATHER) { const int _ri = _h * HALF + _R; const int _row = (_ri < (u).x1) ? (g.rows[(u).x0 + _ri] >> 1) : 0; dst[_h][_i] = (unsigned)((size_t)_row * g.lda + _C) * 2u; } \
        else dst[_h][_i] = (unsigned)((_h * HALF + _R) * g.lda + _C) * 2u; } } while (0)
    Unit cur, nxt; int ui = 0;
    if (!S.next(0, cur)) return;
    f32x4 acc[2][2][4][2];
#pragma unroll
    for (int a = 0; a < 2; ++a)
#pragma unroll
        for (int b = 0; b < 2; ++b)
#pragma unroll
            for (int m = 0; m < 4; ++m)
#pragma unroll
                for (int n = 0; n < 2; ++n) acc[a][b][m][n] = (f32x4){0.f, 0.f, 0.f, 0.f};
    bf16x8 At[4][2], B0[2][2], B1[2][2];
    const char* cA = (const char*)g.A + (GATHER ? (size_t)0 : (size_t)cur.aoff * 2); const char* cB = (const char*)g.Bt + (size_t)cur.boff * 2;
    S.a_ready(cur, wid, lane);
    PG8_AOFFS(vA, cur);
    PG8_STAGE_B(PG8_SB(0, 0), cB); PG8_STAGE_B(PG8_SB(0, 1), cB + hstepB); PG8_STAGE_A(PG8_SA(0, 0), cA, vA, 0); PG8_STAGE_A(PG8_SA(0, 1), cA, vA, 1);
    if (wr == 1) PG8_BAR;
    PG8_WAIT_V(2); PG8_BAR;
    PG8_STAGE_B(PG8_SB(1, 0), cB + kstep); PG8_STAGE_A(PG8_SA(1, 0), cA + kstep, vA, 0); PG8_STAGE_B(PG8_SB(1, 1), cB + hstepB + kstep);
    PG8_WAIT_V(6); PG8_BAR;
    for (;;) {
        const bool has_next = S.next(ui + 1, nxt);
        const char* nA = has_next ? (const char*)g.A + (GATHER ? (size_t)0 : (size_t)nxt.aoff * 2) : cA; const char* nB = has_next ? (const char*)g.Bt + (size_t)nxt.boff * 2 : cB;
#pragma unroll 1
        for (int t = 0; t < nt; t += 2) {
            const bool last = (t == nt - 2);
            if (last && has_next) S.a_ready(nxt, wid, lane);
            const char* a1 = cA + (size_t)(t + 1) * kstep;
            const char* a2 = last ? nA : cA + (size_t)(t + 2) * kstep; const char* b2 = last ? nB : cB + (size_t)(t + 2) * kstep;
            const char* a3 = a2 + kstep; const char* b3 = b2 + kstep;
            PG8_LDB(B0, 0, 0); PG8_LDB(B1, 0, 1); PG8_SCHED; PG8_LDA(At, 0, 0); PG8_STAGE_A(PG8_SA(1, 1), a1, vA, 1);
            PG8_WAIT_V(8); PG8_WAIT_L(0); PG8_BAR; PG8_MMA(0, 0, At, B0); PG8_MMA(0, 1, At, B1); PG8_BAR; PG8_SCHED;
            if (GATHER) { if (last && has_next) { PG8_AOFFS(vA, nxt); } }
            PG8_LDA(At, 0, 1); PG8_STAGE_B(PG8_SB(0, 0), b2); PG8_STAGE_B(PG8_SB(0, 1), b2 + hstepB); PG8_STAGE_A(PG8_SA(0, 0), a2, vA, 0);
            PG8_WAIT_V(8); PG8_WAIT_L(0); PG8_BAR; PG8_MMA(1, 0, At, B0); PG8_MMA(1, 1, At, B1); PG8_BAR; PG8_SCHED;
            PG8_LDB(B0, 1, 0); PG8_LDB(B1, 1, 1); PG8_SCHED; PG8_LDA(At, 1, 0); PG8_STAGE_A(PG8_SA(0, 1), a2, vA, 1);
            PG8_WAIT_V(8); PG8_WAIT_L(0); PG8_BAR; PG8_MMA(0, 0, At, B0); PG8_MMA(0, 1, At, B1); PG8_BAR; PG8_SCHED;
            PG8_LDA(At, 1, 1); PG8_STAGE_B(PG8_SB(1, 0), b3); PG8_STAGE_B(PG8_SB(1, 1), b3 + hstepB); PG8_STAGE_A(PG8_SA(1, 0), a3, vA, 0);
            PG8_WAIT_V(8); PG8_WAIT_L(0); PG8_BAR; PG8_MMA(1, 0, At, B0); PG8_MMA(1, 1, At, B1); PG8_BAR; PG8_SCHED;
        }
        { const int el = lane_id(); E(acc, cur, wr, wc, el & 15, el >> 4); E.done(cur, el); }
        if (!has_next) break;
#pragma unroll
        for (int a = 0; a < 2; ++a)
#pragma unroll
            for (int b = 0; b < 2; ++b)
#pragma unroll
                for (int m = 0; m < 4; ++m)
#pragma unroll
                    for (int n = 0; n < 2; ++n) acc[a][b][m][n] = (f32x4){0.f, 0.f, 0.f, 0.f};
        cur = nxt; cA = nA; cB = nB; ++ui;
    }
    PG8_WAIT_V(0);
    if (wr == 0) PG8_BAR;
    PG8_BAR;
#undef PG8_SA
#undef PG8_SB
#undef PG8_STAGE_A
#undef PG8_STAGE_B
#undef PG8_LDA
#undef PG8_LDB
#undef PG8_MMA
#undef PG8_WAIT_V
#undef PG8_WAIT_L
#undef PG8_BAR
#undef PG8_SCHED
#undef PG8_AOFFS
}
}


__device__ __forceinline__ int perm_s(int s) { return (s & ~12) | (((s >> 2) & 1) << 3) | (((s >> 3) & 1) << 2); }
constexpr float QS_MLA = 0.10206207261596577f * LOG2E;
constexpr float QS_DF = 0.17677669529663687f * LOG2E;

struct EpiIn {
    static constexpr bool PERM = false;
    __device__ __forceinline__ void done(const pg8::Unit&, int) const {}
    unsigned char* ws; const float* b_i; const float* b_f; int layer;
    __device__ __forceinline__ void operator()(const f32x4 (&acc)[2][2][4][2], const pg8::Unit& u, int wr, int wc, int fr, int fq) const {
        const int pn = u.pn, b = u.pm >> 3;
        bf16_t* Z = (bf16_t*)(ws + WS_Z);
        const f32x2* ROPE = (const f32x2*)(ws + WS_ROPE);
        int zbase = -1;
        if (pn <= 3) zbase = pn * 256; else if (pn >= 5 && pn <= 8) zbase = (pn - 1) * 256;
#pragma unroll
        for (int ai = 0; ai < 2; ++ai)
#pragma unroll
            for (int m = 0; m < 4; ++m) {
                const int r = u.pm * 256 + ai * 128 + wr * 64 + m * 16 + fr, s = r & (S - 1);
                if (zbase >= 0) {
#pragma unroll
                    for (int bj = 0; bj < 2; ++bj)
#pragma unroll
                        for (int n = 0; n < 2; ++n) { const f32x4 v = acc[ai][bj][m][n]; u32x2 o; o.x = pk2(v.x, v.y); o.y = pk2(v.z, v.w);
                            *(u32x2*)(Z + (size_t)r * ZLD + zbase + bj * 128 + wc * 32 + n * 16 + fq * 4) = o; }
                }
                if (pn <= 1) {
                    float sq = 0.f, skv = 0.f;
#pragma unroll
                    for (int bj = 0; bj < 2; ++bj) {
                        const int cb = pn * 256 + bj * 128 + wc * 32;
                        float t = 0.f;
#pragma unroll
                        for (int n = 0; n < 2; ++n) { const f32x4 v = acc[ai][bj][m][n]; t += (v.x * v.x + v.y * v.y) + (v.z * v.z + v.w * v.w); }
                        if (cb < 192) sq += t; else if (cb < 320) skv += t;
                    }
                    sq = xor32_sum(xor16_sum(sq)); skv = xor32_sum(xor16_sum(skv));
                    if (fq == 0) *(f32x2*)((float*)(ws + WS_RSP) + ((size_t)r * 8 + pn * 4 + wc) * 2) = (f32x2){sq, skv};
                }
                if (pn == 1 && wc == 2) {
                    const f32x4 x1 = acc[ai][0][m][0], x2 = acc[ai][0][m][1];
                    float o1[4], o2[4];
#pragma unroll
                    for (int j = 0; j < 4; ++j) { const f32x2 cs = ROPE[s * 16 + fq * 4 + j]; o1[j] = x1[j] * cs.x - x2[j] * cs.y; o2[j] = x1[j] * cs.y + x2[j] * cs.x; }
                    u32x2 w1; w1.x = pk2(o1[0], o1[1]); w1.y = pk2(o1[2], o1[3]); u32x2 w2; w2.x = pk2(o2[0], o2[1]); w2.y = pk2(o2[2], o2[3]);
                    bf16_t* KM = (bf16_t*)(ws + WS_KM);
#pragma unroll
                    for (int h = 0; h < 4; ++h) { bf16_t* kr = KM + ((size_t)(b * 4 + h) * S + s) * 96 + 64 + fq * 4; *(u32x2*)kr = w1; *(u32x2*)(kr + 16) = w2; }
                }
                if (pn == 1 && wc == 3 && fq < 2) {
                    const f32x4 v = acc[ai][0][m][0]; const float* bias = (fq == 0 ? b_i : b_f) + layer * 4;
                    float* G = (float*)(ws + WS_GATES) + (size_t)r * 8 + fq * 4;
                    *(f32x4*)G = (f32x4){v.x + bias[0], v.y + bias[1], v.z + bias[2], v.w + bias[3]};
                }
                if (pn == 3 || pn == 4 || pn == 11) {
                    bf16_t* XT = (bf16_t*)(ws + (pn == 3 ? WS_MKT : (pn == 4 ? WS_MVT : WS_DVT)));
                    const int sp = perm_s(s);
#pragma unroll
                    for (int bj = 0; bj < 2; ++bj)
#pragma unroll
                        for (int n = 0; n < 2; ++n) { const f32x4 v = acc[ai][bj][m][n];
                            const int col = bj * 128 + wc * 32 + n * 16 + fq * 4;
#pragma unroll
                            for (int j = 0; j < 4; ++j) { const int c = col + j; XT[((size_t)(b * 4 + (c >> 6)) * 64 + (c & 63)) * S + sp] = (bf16_t)(pk2(v[j], 0.f) & 0xffffu); } }
                }
                if (pn == 9 || pn == 10) {
                    bf16_t* XD = (bf16_t*)(ws + (pn == 9 ? WS_QD : WS_KD)); const float sc = (pn == 9) ? QS_DF : 1.0f;
#pragma unroll
                    for (int bj = 0; bj < 2; ++bj) {
                        const f32x4 x1 = acc[ai][bj][m][0], x2 = acc[ai][bj][m][1];
                        float o1[4], o2[4];
#pragma unroll
                        for (int j = 0; j < 4; ++j) { const f32x2 cs = ROPE[s * 16 + fq * 4 + j]; o1[j] = (x1[j] * cs.x - x2[j] * cs.y) * sc; o2[j] = (x1[j] * cs.y + x2[j] * cs.x) * sc; }
                        u32x2 w1; w1.x = pk2(o1[0], o1[1]); w1.y = pk2(o1[2], o1[3]); u32x2 w2; w2.x = pk2(o2[0], o2[1]); w2.y = pk2(o2[2], o2[3]);
                        bf16_t* dst = XD + ((size_t)(b * 8 + bj * 4 + wc) * S + s) * 32 + fq * 4; *(u32x2*)dst = w1; *(u32x2*)(dst + 16) = w2;
                    }
                }
            }
    }
};

struct EpiUp {
    static constexpr bool PERM = false;
    __device__ __forceinline__ void done(const pg8::Unit&, int) const {}
    unsigned char* ws; int layer;
    __device__ __forceinline__ void operator()(const f32x4 (&acc)[2][2][4][2], const pg8::Unit& u, int wr, int wc, int fr, int fq) const {
        const int pn = u.pn, b = u.pm >> 3;
        const f32x2* ROPE = (const f32x2*)(ws + WS_ROPE);
        bf16_t* QM = (bf16_t*)(ws + WS_QM); bf16_t* KM = (bf16_t*)(ws + WS_KM); bf16_t* VT = (bf16_t*)(ws + WS_VTM);
#pragma unroll
        for (int ai = 0; ai < 2; ++ai)
#pragma unroll
            for (int m = 0; m < 4; ++m) {
                const int r = u.pm * 256 + ai * 128 + wr * 64 + m * 16 + fr, s = r & (S - 1);
                f32x2 ss = (f32x2){0.f, 0.f};
                { const f32x4* rp = (const f32x4*)((const float*)(ws + WS_RSP) + (size_t)r * 16);
#pragma unroll
                  for (int q4 = 0; q4 < 4; ++q4) { const f32x4 t4 = rp[q4]; ss.x += t4.x + t4.z; ss.y += t4.y + t4.w; } }
                const float rq = __builtin_amdgcn_rsqf(ss.x * (1.0f / 192.0f) + RMS_EPS), rkv = __builtin_amdgcn_rsqf(ss.y * (1.0f / 128.0f) + RMS_EPS);
                if (pn == 0 || pn == 2) {
                    bf16_t* X = (pn == 0) ? QM : KM; const float sc = (pn == 0) ? rq * QS_MLA : rkv;
#pragma unroll
                    for (int bj = 0; bj < 2; ++bj)
#pragma unroll
                        for (int n = 0; n < 2; ++n) { const f32x4 v = acc[ai][bj][m][n] * sc; const int col = bj * 128 + wc * 32 + n * 16 + fq * 4;
                            u32x2 o; o.x = pk2(v.x, v.y); o.y = pk2(v.z, v.w);
                            *(u32x2*)(X + ((size_t)(b * 4 + (col >> 6)) * S + s) * 96 + (col & 63)) = o; }
                } else if (pn == 1) {
                    const f32x4 x1 = acc[ai][0][m][0], x2 = acc[ai][0][m][1]; const float sc = rq * QS_MLA;
                    float o1[4], o2[4];
#pragma unroll
                    for (int j = 0; j < 4; ++j) { const f32x2 cs = ROPE[s * 16 + fq * 4 + j]; o1[j] = (x1[j] * cs.x - x2[j] * cs.y) * sc; o2[j] = (x1[j] * cs.y + x2[j] * cs.x) * sc; }
                    u32x2 w1; w1.x = pk2(o1[0], o1[1]); w1.y = pk2(o1[2], o1[3]); u32x2 w2; w2.x = pk2(o2[0], o2[1]); w2.y = pk2(o2[2], o2[3]);
                    bf16_t* dst = QM + ((size_t)(b * 4 + wc) * S + s) * 96 + 64 + fq * 4; *(u32x2*)dst = w1; *(u32x2*)(dst + 16) = w2;
                } else {
                    const int sp = perm_s(s);
#pragma unroll
                    for (int bj = 0; bj < 2; ++bj)
#pragma unroll
                        for (int n = 0; n < 2; ++n) { const f32x4 v = acc[ai][bj][m][n] * rkv; const int col = bj * 128 + wc * 32 + n * 16 + fq * 4;
#pragma unroll
                            for (int j = 0; j < 4; ++j) { const int c = col + j; VT[((size_t)(b * 4 + (c >> 6)) * 64 + (c & 63)) * S + sp] = (bf16_t)(pk2(v[j], 0.f) & 0xffffu); } }
                }
            }
    }
};

struct EpiOut {
    static constexpr bool PERM = true;
    __device__ __forceinline__ void done(const pg8::Unit&, int) const {}
    unsigned char* ws; const float* bada; const bf16_t* xin; int layer;
    __device__ __forceinline__ void operator()(const f32x4 (&acc)[2][2][4][2], const pg8::Unit& u, int wr, int wc, int fr, int fq) const {
        const int b = u.pm >> 3; bf16_t* PRE = (bf16_t*)(ws + WS_PRE);
#pragma unroll
        for (int bj = 0; bj < 2; ++bj) {
            const int c = u.pn * 256 + bj * 128 + wc * 32 + fq * 8;
            const f32x4 g1a = mod4p(ws, bada, layer, b, 2048 + c), g1b = mod4p(ws, bada, layer, b, 2048 + c + 4);
#pragma unroll
            for (int ai = 0; ai < 2; ++ai)
#pragma unroll
                for (int m = 0; m < 4; ++m) {
                    const int r = u.pm * 256 + ai * 128 + wr * 64 + m * 16 + fr;
                    const u32x4 xw = *(const u32x4*)(xin + (size_t)r * D + c);
                    const f32x4 xa = (f32x4){bflo(xw.x), bfhi(xw.x), bflo(xw.y), bfhi(xw.y)}, xb = (f32x4){bflo(xw.z), bfhi(xw.z), bflo(xw.w), bfhi(xw.w)};
                    const f32x4 pa = xa * DN_ALPHA + g1a * acc[ai][bj][m][0], pb = xb * DN_ALPHA + g1b * acc[ai][bj][m][1];
                    u32x4 o; o.x = pk2(pa.x, pa.y); o.y = pk2(pa.z, pa.w); o.z = pk2(pb.x, pb.y); o.w = pk2(pb.z, pb.w);
                    *(u32x4*)(PRE + (size_t)r * D + c) = o;
                }
        }
    }
};


constexpr int MOE_MAXT = 160;
constexpr int LM_NT = 16, LM_TT = 32, LM_VV = 32 + MOE_MAXT, LM_EB = 32 + 2 * MOE_MAXT, LM_EN = LM_EB + 16;

__device__ __forceinline__ float top2sum4(float a, float b, float c, float d) {
    return fmaxf(fmaxf(fmaxf(a + b, a + c), fmaxf(a + d, b + c)), fmaxf(b + d, c + d));
}
__device__ __forceinline__ void route_select(const float (&lg)[16], const float* br, int& e0, int& e1, float& w0, float& w1) {
    float sc[16], sel[16];
#pragma unroll
    for (int e = 0; e < 16; ++e) { sc[e] = __builtin_amdgcn_rcpf(1.0f + __expf(-lg[e])); sel[e] = sc[e] + br[e]; }
    float gs[4];
#pragma unroll
    for (int g = 0; g < 4; ++g) gs[g] = top2sum4(sel[4 * g], sel[4 * g + 1], sel[4 * g + 2], sel[4 * g + 3]);
    int gb = 0; float gv = gs[0];
#pragma unroll
    for (int g = 1; g < 4; ++g) if (gs[g] > gv) { gv = gs[g]; gb = g; }
    float s4[4], c4[4];
#pragma unroll
    for (int i = 0; i < 4; ++i) { s4[i] = gb == 0 ? sel[i] : gb == 1 ? sel[4 + i] : gb == 2 ? sel[8 + i] : sel[12 + i]; c4[i] = gb == 0 ? sc[i] : gb == 1 ? sc[4 + i] : gb == 2 ? sc[8 + i] : sc[12 + i]; }
    int i0 = 0; float v0 = s4[0], cw0 = c4[0];
#pragma unroll
    for (int i = 1; i < 4; ++i) if (s4[i] > v0) { v0 = s4[i]; i0 = i; cw0 = c4[i]; }
    int i1 = -1; float v1 = -INFINITY, cw1 = 0.f;
#pragma unroll
    for (int i = 0; i < 4; ++i) if (i != i0 && s4[i] > v1) { v1 = s4[i]; i1 = i; cw1 = c4[i]; }
    e0 = gb * 4 + i0; e1 = gb * 4 + i1; const float inv = __builtin_amdgcn_rcpf(cw0 + cw1); w0 = cw0 * inv; w1 = cw1 * inv;
}

template <class NF>
__device__ __forceinline__ int xq_claim(unsigned* qbase, int xcc, bool& own_live, const NF& nof) {
    const int lane = lane_id();
    if (own_live) {
        unsigned j = 0; if (lane == 0) j = __hip_atomic_fetch_add(qbase + 64 * xcc, 1u, __ATOMIC_RELAXED, __HIP_MEMORY_SCOPE_AGENT);
        j = (unsigned)__builtin_amdgcn_readfirstlane((int)j);
        if (j < nof(xcc)) return (xcc << 16) | (int)j;
        own_live = false;
    }
    for (int it = 0; it < 8; ++it) {
        const int q = (xcc + (lane & 7)) & 7;
        unsigned c = 0xffffffffu; if (lane < 8) c = __hip_atomic_load(qbase + 64 * q, __ATOMIC_RELAXED, __HIP_MEMORY_SCOPE_AGENT);
        const unsigned long long m = __ballot(lane < 8 && c < nof(q));
        if (m == 0ull) return -1;
        const int qs = (xcc + (__ffsll((long long)m) - 1)) & 7;
        unsigned j = 0; if (lane == 0) j = __hip_atomic_fetch_add(qbase + 64 * qs, 1u, __ATOMIC_RELAXED, __HIP_MEMORY_SCOPE_AGENT);
        j = (unsigned)__builtin_amdgcn_readfirstlane((int)j);
        if (j < nof(qs)) return (qs << 16) | (int)j;
    }
    return -1;
}
__device__ __forceinline__ void moe_tile_table(const Frame& F0, int layer) {
    const Frame F = phase_frame(F0);
    volatile LAS unsigned* MISC = (volatile LAS unsigned*)(F.lds + LDS_MISC);
    __syncthreads();
    if (F.wave == 0) {
        const int e = F.lane; int cnt = 0;
        if (e < NEXP) cnt = (int)__hip_atomic_load(F.ctl + CW_CNT + 64 * (16 * layer + e), __ATOMIC_RELAXED, __HIP_MEMORY_SCOPE_AGENT);
        const int ntl = (cnt + 255) >> 8; int incl = ntl;
#define SCAN_STEP(CTRL) incl += __builtin_amdgcn_update_dpp(0, incl, CTRL, 0xf, 0xf, false)
        SCAN_STEP(0x111); SCAN_STEP(0x112); SCAN_STEP(0x114); SCAN_STEP(0x118);
#undef SCAN_STEP
        const int base = incl - ntl;
        for (int t = 0; t < ntl; ++t) { const int gt = base + t; if (gt < MOE_MAXT) { MISC[LM_TT + gt] = ((unsigned)e << 16) | (unsigned)t; const int v = cnt - t * 256; MISC[LM_VV + gt] = (unsigned)(v < 256 ? v : 256); } }
        if (e < NEXP) { MISC[LM_EB + e] = (unsigned)base; MISC[LM_EN + e] = (unsigned)ntl; }
        if (e == NEXP - 1) MISC[LM_NT] = (unsigned)(incl < MOE_MAXT ? incl : MOE_MAXT);
    }
    __syncthreads();
}
struct MoeOrder {
    const volatile LAS unsigned* MISC; int npn, which;
    unsigned* queue; int wave;
    unsigned* ready;
    int xcc; mutable bool own_live;
    __device__ __forceinline__ void a_ready(const pg8::Unit& u, int wid, int lane) const {
        if (which != 2) return;
        if (wid == 0) { unsigned spins = 0;
            while ((unsigned)__builtin_amdgcn_readfirstlane((int)__hip_atomic_load(ready + 64 * u.pm, __ATOMIC_RELAXED, __HIP_MEMORY_SCOPE_AGENT)) < 16u) { __builtin_amdgcn_s_sleep(2); if (++spins > (1u << 22)) break; }
            __builtin_amdgcn_fence(__ATOMIC_ACQUIRE, "agent");
            asm volatile("s_waitcnt vmcnt(0)" ::: "memory"); }
        asm volatile("" ::: "memory"); __builtin_amdgcn_s_barrier(); asm volatile("" ::: "memory");
    }
    __device__ bool next(int i, pg8::Unit& u) const {
        volatile LAS unsigned* slot = const_cast<volatile LAS unsigned*>(MISC) + 24 + (i & 1);
        const int sh = (npn == 4) ? 2 : 1;
        if (wave == 0) {
            const volatile LAS unsigned* M = MISC;
            const int r = xq_claim(queue, xcc, own_live, [M, sh](int q) { return (unsigned)((M[LM_EN + q] + M[LM_EN + q + 8]) << sh); });
            if (lane_id() == 0) *slot = (unsigned)r;
            asm volatile("s_waitcnt vmcnt(0) lgkmcnt(0)" ::: "memory"); }
        asm volatile("" ::: "memory"); __builtin_amdgcn_s_barrier(); asm volatile("" ::: "memory");
        const int L = __builtin_amdgcn_readfirstlane((int)*slot); if (L < 0) return false;
        const int q = L >> 16, j = L & 0xffff, jt = j >> sh, pn = j & (npn - 1);
        const int n1 = __builtin_amdgcn_readfirstlane((int)MISC[LM_EN + q]);
        const int gt = jt < n1 ? __builtin_amdgcn_readfirstlane((int)MISC[LM_EB + q]) + jt : __builtin_amdgcn_readfirstlane((int)MISC[LM_EB + q + 8]) + (jt - n1);
        const unsigned tt = (unsigned)__builtin_amdgcn_readfirstlane((int)MISC[LM_TT + gt]); const int e = (int)(tt >> 16), tile = (int)(tt & 0xffffu);
        u.pm = gt; u.pn = pn; u.x0 = e * T + tile * 256; u.x1 = __builtin_amdgcn_readfirstlane((int)MISC[LM_VV + gt]);
        if (which == 1) { u.aoff = 0; u.boff = ((long)e * 512 + pn * 256) * 1024; }
        else { u.aoff = (long)gt * 256 * 256; u.boff = ((long)e * 1024 + pn * 256) * 256; }
        return true;
    }
};
struct EpiMoe1 {
    static constexpr bool PERM = true;
    unsigned char* ws; unsigned* ready;
    __device__ __forceinline__ void done(const pg8::Unit& u, int lane) const {
        asm volatile("s_waitcnt vmcnt(0)" ::: "memory");
        if (lane == 0) __hip_atomic_fetch_add(ready + 64 * u.pm, 1u, __ATOMIC_RELAXED, __HIP_MEMORY_SCOPE_AGENT);
    }
    __device__ __forceinline__ void operator()(const f32x4 (&acc)[2][2][4][2], const pg8::Unit& u, int wr, int wc, int fr, int fq) const {
        const int* LIST = (const int*)(ws + WS_LIST); const float* ROUTE = (const float*)(ws + WS_ROUTE);
        const __amdgpu_buffer_rsrc_t hres = __builtin_amdgcn_make_buffer_rsrc(ws + WS_H, 0, MOE_MAXT * 256 * 256 * 2, 0x00020000);
#pragma unroll
        for (int ai = 0; ai < 2; ++ai)
#pragma unroll
            for (int m = 0; m < 4; ++m) {
                const int ri = ai * 128 + wr * 64 + m * 16 + fr;
                float gate = 0.f;
                if (ri < u.x1) { const int code = LIST[u.x0 + ri]; gate = ROUTE[code]; }
                u32x4 o;
                { const f32x4 a1 = acc[ai][0][m][0], a3 = acc[ai][1][m][0]; f32x4 h;
#pragma unroll
                  for (int j = 0; j < 4; ++j) h[j] = a1[j] * __builtin_amdgcn_rcpf(1.0f + __expf(-a1[j])) * a3[j] * gate;
                  o.x = pk2(h.x, h.y); o.y = pk2(h.z, h.w); }
                { const f32x4 a1 = acc[ai][0][m][1], a3 = acc[ai][1][m][1]; f32x4 h;
#pragma unroll
                  for (int j = 0; j < 4; ++j) h[j] = a1[j] * __builtin_amdgcn_rcpf(1.0f + __expf(-a1[j])) * a3[j] * gate;
                  o.z = pk2(h.x, h.y); o.w = pk2(h.z, h.w); }
                __builtin_amdgcn_raw_buffer_store_b128(o, hres, (int)((((size_t)u.pm * 256 + ri) * 256 + u.pn * 128 + wc * 32 + fq * 8) * 2), 0, 16);
            }
    }
};
struct EpiMoe2 {
    static constexpr bool PERM = true;
    __device__ __forceinline__ void done(const pg8::Unit&, int) const {}
    unsigned char* ws;
    __device__ __forceinline__ void operator()(const f32x4 (&acc)[2][2][4][2], const pg8::Unit& u, int wr, int wc, int fr, int fq) const {
        bf16_t* YB = (bf16_t*)(ws + WS_YB); const int* LIST = (const int*)(ws + WS_LIST);
#pragma unroll
        for (int ai = 0; ai < 2; ++ai)
#pragma unroll
            for (int m = 0; m < 4; ++m) {
                const int ri = ai * 128 + wr * 64 + m * 16 + fr;
                if (ri < u.x1) { const int code = LIST[u.x0 + ri];
#pragma unroll
                    for (int bj = 0; bj < 2; ++bj) { const f32x4 v0 = acc[ai][bj][m][0], v1 = acc[ai][bj][m][1];
                        u32x4 o; o.x = pk2(v0.x, v0.y); o.y = pk2(v0.z, v0.w); o.z = pk2(v1.x, v1.y); o.w = pk2(v1.z, v1.w);
                        *(u32x4*)(YB + (size_t)code * D + u.pn * 256 + bj * 128 + wc * 32 + fq * 8) = o; } }
            }
    }
};


__device__ __forceinline__ int queue_next(const Frame& F, int qi) {
    volatile LAS int* slot = (volatile LAS int*)(F.lds + LDS_MISC + 64);
    __syncthreads();
    if (F.tid == 0) *slot = (int)__hip_atomic_fetch_add(F.ctl + CW_Q + 64 * qi, 1u, __ATOMIC_RELAXED, __HIP_MEMORY_SCOPE_AGENT);
    __syncthreads();
    return __builtin_amdgcn_readfirstlane(*slot);
}

__device__ __forceinline__ int queue_next_xcd(const Frame& F, int qi, int xcc, int nitems, bool& own_live) {
    volatile LAS int* slot = (volatile LAS int*)(F.lds + LDS_MISC + 64);
    __syncthreads();
    if (F.wave == 0) {
        const int r = xq_claim(F.ctl + CW_Q + 64 * (qi * 8), xcc, own_live, [nitems](int) { return (unsigned)nitems; });
        if (lane_id() == 0) *slot = r;
    }
    __syncthreads();
    return __builtin_amdgcn_readfirstlane(*slot);
}

__device__ __forceinline__ int crow(int r, int h) { return (r & 3) + 8 * (r >> 2) + 4 * h; }
template <int DK>
struct AttnLds { static constexpr int KSTR = DK * 2 + 16, VSTR = 272, KB = 128 * KSTR, VB = 64 * VSTR, K0 = 0, K1 = KB, V0 = 2 * KB, TOTAL = 2 * KB + 3 * VB; };

template <int DK>
__device__ __forceinline__ void attn_map(const Frame& F, const bf16_t* Qp, const bf16_t* Kp, const bf16_t* VTp, int qb, f32x16 (&o)[2], float& lsum) {
    typedef AttnLds<DK> L;
    constexpr int KS = DK / 16, KPR = DK * 2 / 16;
    constexpr int NKP = 128 * KPR, NKI = (NKP + 511) / 512;
    const int lane = F.lane, r32 = lane & 31, h = lane >> 5, wave = F.wave, tid = F.tid;
    LAS unsigned char* lds = F.lds;
    const int q = qb * 256 + wave * 32 + r32;
    bf16x8 qf[KS];
#pragma unroll
    for (int s = 0; s < KS; ++s) qf[s] = *(const bf16x8*)(Qp + (size_t)q * DK + s * 16 + h * 8);
    const int NT = 2 * qb + 2, tmax = 2 * qb + (wave >> 2);
    const bool defer = wave >= 4;
    float m_run = -INFINITY, l_run = 0.f;
#pragma unroll
    for (int i = 0; i < 16; ++i) { o[0][i] = 0.f; o[1][i] = 0.f; }
    u32x4 kreg[NKI], vreg[2];
#pragma unroll
    for (int i = 0; i < NKI; ++i) kreg[i] = (u32x4){0u, 0u, 0u, 0u};
    u32x4 pws[8];
#pragma unroll
    for (int i = 0; i < 8; ++i) pws[i] = (u32x4){0u, 0u, 0u, 0u};
    int pend_slot = -1;
#define ATT_LOAD(t) do { _Pragma("unroll") for (int i_ = 0; i_ < NKI; ++i_) { const int p_ = tid + 512 * i_; if (NKP % 512 == 0 || p_ < NKP) kreg[i_] = *(const u32x4*)(Kp + ((size_t)(t) * 128 + p_ / KPR) * DK + (p_ % KPR) * 8); } \
        _Pragma("unroll") for (int i_ = 0; i_ < 2; ++i_) { const int p_ = tid + 512 * i_; vreg[i_] = *(const u32x4*)(VTp + (size_t)(p_ >> 4) * S + (t) * 128 + (p_ & 15) * 8); } } while (0)
#define ATT_STORE(kbuf, vslot) do { _Pragma("unroll") for (int i_ = 0; i_ < NKI; ++i_) { const int p_ = tid + 512 * i_; if (NKP % 512 == 0 || p_ < NKP) *(LAS u32x4*)(lds + ((kbuf) ? L::K1 : L::K0) + (p_ / KPR) * L::KSTR + (p_ % KPR) * 16) = kreg[i_]; } \
        _Pragma("unroll") for (int i_ = 0; i_ < 2; ++i_) { const int p_ = tid + 512 * i_; *(LAS u32x4*)(lds + L::V0 + (vslot) + (p_ >> 4) * L::VSTR + (p_ & 15) * 16) = vreg[i_]; } } while (0)
#define ATT_PV(vslot) do { const LAS unsigned char* vb_ = lds + L::V0 + (vslot) + r32 * L::VSTR + h * 16; bf16x8 vfa_[4], vfb_[4]; \
        _Pragma("unroll") for (int f_ = 0; f_ < 4; ++f_) vfa_[f_] = *(const LAS bf16x8*)(vb_ + (f_ & 1) * 32 * L::VSTR + ((f_ >> 1) * 16) * 2); \
        _Pragma("unroll") for (int b4_ = 0; b4_ < 4; ++b4_) { \
            if (b4_ < 3) { _Pragma("unroll") for (int f_ = 0; f_ < 4; ++f_) { const bf16x8 nf_ = *(const LAS bf16x8*)(vb_ + (f_ & 1) * 32 * L::VSTR + ((b4_ + 1) * 32 + (f_ >> 1) * 16) * 2); if (b4_ & 1) vfa_[f_] = nf_; else vfb_[f_] = nf_; } } \
            __builtin_amdgcn_sched_barrier(0); \
            _Pragma("unroll") for (int s2_ = 0; s2_ < 2; ++s2_) { const bf16x8 bfrag_ = __builtin_bit_cast(bf16x8, pws[b4_ * 2 + s2_]); \
                _Pragma("unroll") for (int db_ = 0; db_ < 2; ++db_) o[db_] = __builtin_amdgcn_mfma_f32_32x32x16_bf16((b4_ & 1) ? vfb_[s2_ * 2 + db_] : vfa_[s2_ * 2 + db_], bfrag_, o[db_], 0, 0, 0); } } } while (0)
    __syncthreads();
    ATT_LOAD(0); ATT_STORE(0, 0);
    __syncthreads();
    int vs_cur = 0;
    for (int t = 0; t < NT; ++t) {
        const int buf = t & 1;
        const int vs_next = (vs_cur == 2 * L::VB) ? 0 : vs_cur + L::VB;
        if (t + 1 < NT) ATT_LOAD(t + 1);
        if (pend_slot >= 0) { ATT_PV(pend_slot); pend_slot = -1; }
        if (t <= tmax) {
            const LAS unsigned char* kb = lds + (buf ? L::K1 : L::K0) + r32 * L::KSTR + h * 16;
            f32x16 p[4];
            bf16x8 kfa[KS], kfb[KS];
#pragma unroll
            for (int s = 0; s < KS; ++s) kfa[s] = *(const LAS bf16x8*)(kb + s * 32);
#pragma unroll
            for (int b4 = 0; b4 < 4; ++b4) {
#pragma unroll
                for (int i = 0; i < 16; ++i) p[b4][i] = 0.f;
                if (b4 < 3) {
#pragma unroll
                    for (int s = 0; s < KS; ++s) { const bf16x8 nf = *(const LAS bf16x8*)(kb + (b4 + 1) * 32 * L::KSTR + s * 32); if (b4 & 1) kfa[s] = nf; else kfb[s] = nf; } }
                __builtin_amdgcn_sched_barrier(0);
#pragma unroll
                for (int s = 0; s < KS; ++s) p[b4] = __builtin_amdgcn_mfma_f32_32x32x16_bf16((b4 & 1) ? kfb[s] : kfa[s], qf[s], p[b4], 0, 0, 0);
            }
            if (t == tmax) {
                const int kbase = t * 128 + 4 * h;
#pragma unroll
                for (int b4 = 0; b4 < 4; ++b4)
#pragma unroll
                    for (int r = 0; r < 16; ++r) { const int kv = kbase + b4 * 32 + (r & 3) + 8 * (r >> 2); if (kv > q) p[b4][r] = -INFINITY; }
            }
            float mx = p[0][0];
#pragma unroll
            for (int b4 = 0; b4 < 4; ++b4)
#pragma unroll
                for (int r = 0; r < 16; ++r) mx = fmaxf(mx, p[b4][r]);
            mx = xor32_max(mx);
            const float m_new = fmaxf(m_run, mx);
            const bool grew = __any(m_new != m_run);
            const float alpha = grew ? __builtin_amdgcn_exp2f(m_run - m_new) : 1.0f;
            m_run = m_new;
            float rs = 0.f;
#pragma unroll
            for (int b4 = 0; b4 < 4; ++b4)
#pragma unroll
                for (int r = 0; r < 16; ++r) { p[b4][r] = __builtin_amdgcn_exp2f(p[b4][r] - m_new); rs += p[b4][r]; }
            if (grew) { l_run *= alpha;
#pragma unroll
                for (int i = 0; i < 16; ++i) { o[0][i] *= alpha; o[1][i] *= alpha; } }
            l_run += rs;
#pragma unroll
            for (int b4 = 0; b4 < 4; ++b4)
#pragma unroll
                for (int s2 = 0; s2 < 2; ++s2) { u32x4 pw; pw.x = pk2(p[b4][8 * s2], p[b4][8 * s2 + 1]); pw.y = pk2(p[b4][8 * s2 + 2], p[b4][8 * s2 + 3]); pw.z = pk2(p[b4][8 * s2 + 4], p[b4][8 * s2 + 5]); pw.w = pk2(p[b4][8 * s2 + 6], p[b4][8 * s2 + 7]);
                    pws[b4 * 2 + s2] = pw; }
            if (defer) pend_slot = vs_cur; else ATT_PV(vs_cur);
        }
        if (t + 1 < NT) ATT_STORE(buf ^ 1, vs_next);
        __syncthreads();
        vs_cur = vs_next;
    }
    if (pend_slot >= 0) ATT_PV(pend_slot);
#undef ATT_LOAD
#undef ATT_STORE
#undef ATT_PV
    lsum = xor32_sum(l_run);
}

__device__ __forceinline__ void mla_unit(const Args& a, const Frame& F0, int bh, int qb) {
    const Frame F = phase_frame(F0);
    const bf16_t* Qp = (const bf16_t*)(a.ws + WS_QM) + (size_t)bh * S * 96;
    const bf16_t* Kp = (const bf16_t*)(a.ws + WS_KM) + (size_t)bh * S * 96;
    const bf16_t* VTp = (const bf16_t*)(a.ws + WS_VTM) + (size_t)bh * 64 * S;
    f32x16 o[2]; float l;
    attn_map<96>(F, Qp, Kp, VTp, qb, o, l);
    const float inv = 1.0f / l;
    const int r32 = F.lane & 31, h = F.lane >> 5, b = bh >> 2, head = bh & 3;
    bf16_t* orow = (bf16_t*)(a.ws + WS_MIX) + ((size_t)b * S + qb * 256 + F.wave * 32 + r32) * D + head * 64;
#pragma unroll
    for (int db = 0; db < 2; ++db)
#pragma unroll
        for (int g = 0; g < 4; ++g) { u32x2 w; w.x = pk2(o[db][4 * g] * inv, o[db][4 * g + 1] * inv); w.y = pk2(o[db][4 * g + 2] * inv, o[db][4 * g + 3] * inv);
            *(u32x2*)(orow + db * 32 + 8 * g + 4 * h) = w; }
}
__device__ __forceinline__ void diff_unit(const Args& a, const Frame& F0, int layer, int bh, int qb) {
    const Frame F = phase_frame(F0);
    const int b = bh >> 2, head = bh & 3;
    const bf16_t* VTp = (const bf16_t*)(a.ws + WS_DVT) + (size_t)bh * 64 * S;
    f32x16 oa[2], ob[2]; float la, lb;
    { const size_t off = ((size_t)(b * 8 + head * 2) * S) * 32; attn_map<32>(F, (const bf16_t*)(a.ws + WS_QD) + off, (const bf16_t*)(a.ws + WS_KD) + off, VTp, qb, oa, la); }
    { const size_t off = ((size_t)(b * 8 + head * 2 + 1) * S) * 32; attn_map<32>(F, (const bf16_t*)(a.ws + WS_QD) + off, (const bf16_t*)(a.ws + WS_KD) + off, VTp, qb, ob, lb); }
    float d1 = 0.f, d2 = 0.f;
    if (F.lane < 32) { d1 = a.in[I_LQ1][layer * 32 + F.lane] * a.in[I_LK1][layer * 32 + F.lane]; d2 = a.in[I_LQ2][layer * 32 + F.lane] * a.in[I_LK2][layer * 32 + F.lane]; }
    d1 = wave_sum(d1); d2 = wave_sum(d2);
    const float lam_init = 0.8f - 0.6f * expf(-0.3f * (float)layer);
    const float lam = expf(d1) - expf(d2) + lam_init;
    const float ia = 1.0f / la, ib = lam / lb;
    float ss = 0.f;
#pragma unroll
    for (int db = 0; db < 2; ++db)
#pragma unroll
        for (int i = 0; i < 16; ++i) { oa[db][i] = oa[db][i] * ia - ob[db][i] * ib; ss += oa[db][i] * oa[db][i]; }
    ss = xor32_sum(ss);
    const float rn = (1.0f / sqrtf(ss * (1.0f / 64.0f) + RMS_EPS)) * (1.0f - lam_init);
    const int r32 = F.lane & 31, h = F.lane >> 5;
    bf16_t* orow = (bf16_t*)(a.ws + WS_MIX) + ((size_t)b * S + qb * 256 + F.wave * 32 + r32) * D + 768 + head * 64;
    const float* gs = a.in[I_DFG] + layer * 64;
#pragma unroll
    for (int db = 0; db < 2; ++db)
#pragma unroll
        for (int g = 0; g < 4; ++g) { const int dv = db * 32 + 8 * g + 4 * h; const f32x4 gv = *(const f32x4*)(gs + dv);
            u32x2 w; w.x = pk2(oa[db][4 * g] * rn * gv.x, oa[db][4 * g + 1] * rn * gv.y); w.y = pk2(oa[db][4 * g + 2] * rn * gv.z, oa[db][4 * g + 3] * rn * gv.w);
            *(u32x2*)(orow + dv) = w; }
}

__device__ __forceinline__ void conv_item(const Args& a, const Frame& F0, int layer, int item) {
    const Frame F = phase_frame(F0);
    const bf16_t* Z = (const bf16_t*)(a.ws + WS_Z); bf16_t* MIXp = (bf16_t*)(a.ws + WS_MIX); const float* W = a.in[I_SCW] + (size_t)layer * 3 * 256;
    for (int i = item * 4096 + F.tid; i < (item + 1) * 4096; i += NTHREADS) {
        const int t = i >> 5, c8 = (i & 31) * 8, s = t & (S - 1);
        const bf16_t* zr = Z + (size_t)t * ZLD;
        const u32x4 cb = *(const u32x4*)(zr + 1280 + c8);
        float acc[8];
#pragma unroll
        for (int j = 0; j < 8; ++j) acc[j] = 0.f;
#pragma unroll
        for (int w = 0; w < 3; ++w) {
            const int back = 2 - w;
            if (s >= back) {
                const u32x4 cc = *(const u32x4*)(zr - (size_t)back * ZLD + 1536 + c8), ch = *(const u32x4*)(zr - (size_t)back * ZLD + 1792 + c8);
                const f32x4 w0 = *(const f32x4*)(W + w * 256 + c8), w1 = *(const f32x4*)(W + w * 256 + c8 + 4);
                acc[0] += w0.x * bflo(cc.x) * bflo(ch.x); acc[1] += w0.y * bfhi(cc.x) * bfhi(ch.x); acc[2] += w0.z * bflo(cc.y) * bflo(ch.y); acc[3] += w0.w * bfhi(cc.y) * bfhi(ch.y);
                acc[4] += w1.x * bflo(cc.z) * bflo(ch.z); acc[5] += w1.y * bfhi(cc.z) * bfhi(ch.z); acc[6] += w1.z * bflo(cc.w) * bflo(ch.w); acc[7] += w1.w * bfhi(cc.w) * bfhi(ch.w);
            }
        }
        u32x4 o; o.x = pk2(acc[0] * bflo(cb.x), acc[1] * bfhi(cb.x)); o.y = pk2(acc[2] * bflo(cb.y), acc[3] * bfhi(cb.y)); o.z = pk2(acc[4] * bflo(cb.z), acc[5] * bfhi(cb.z)); o.w = pk2(acc[6] * bflo(cb.w), acc[7] * bfhi(cb.w));
        *(u32x4*)(MIXp + (size_t)t * D + 512 + c8) = o;
#if MK_MIXER < 3 || defined(MK_EXP_NOSTAGE3)
        { const u32x4 zz = (u32x4){0u, 0u, 0u, 0u};
#if MK_MIXER < 2
          *(u32x4*)(MIXp + (size_t)t * D + c8) = zz; *(u32x4*)(MIXp + (size_t)t * D + 768 + c8) = zz;
#endif
          *(u32x4*)(MIXp + (size_t)t * D + 256 + c8) = zz; }
#endif
    }
}


constexpr int ML_STR = 144;
constexpr int ML_TILE = 64 * ML_STR;
constexpr int ML_GRP = 4 * ML_TILE + 2048;
__device__ __forceinline__ int unperm_p(int p) { return perm_s(p); }
__device__ __forceinline__ float logsigmoidf_(float x) { return x >= 0.f ? -log1pf(expf(-x)) : x - log1pf(expf(x)); }

__device__ __forceinline__ void ml_gates(const Args& a, int lane, int b, int h, int c, LAS float* vec, float& bc, float& gi) {
    const int t = b * S + c * 64 + lane;
    const float* G = (const float*)(a.ws + WS_GATES) + (size_t)t * 8;
#ifdef MK_EXP_CONSTGATES
    gi = 0.0f; const float lf = -0.01f; (void)G;
#else
    gi = G[h]; const float lf = logsigmoidf_(G[4 + h]);
#endif
    vec[128 + lane] = lf;
    LDS_WAIT(); asm volatile("" ::: "memory");
    float acc = 0.f;
    for (int s = 0; s < 64; ++s) { const float v = vec[128 + s]; acc += (s <= lane) ? v : 0.f; }
    bc = acc;
}

__device__ __forceinline__ float readlane_f(float v, int l) { return __int_as_float(__builtin_amdgcn_readlane(__float_as_int(v), l)); }
__device__ __forceinline__ float wave_scan_sum(float v, int lane) {
#define SCAN_STEP(CTRL) v += __int_as_float(__builtin_amdgcn_update_dpp(0, __float_as_int(v), CTRL, 0xf, 0xf, false))
    SCAN_STEP(0x111); SCAN_STEP(0x112); SCAN_STEP(0x114); SCAN_STEP(0x118);
#undef SCAN_STEP
    const float t0 = readlane_f(v, 15), t1 = readlane_f(v, 31), t2 = readlane_f(v, 47);
    const int row = lane >> 4;
    return v + (row >= 1 ? t0 : 0.f) + (row >= 2 ? t1 : 0.f) + (row >= 3 ? t2 : 0.f);
}
__device__ __forceinline__ float wave_scan_max(float v, int lane) {
    const int ninf = __float_as_int(-INFINITY);
#define SCAN_STEP(CTRL) v = fmaxf(v, __int_as_float(__builtin_amdgcn_update_dpp(ninf, __float_as_int(v), CTRL, 0xf, 0xf, false)))
    SCAN_STEP(0x111); SCAN_STEP(0x112); SCAN_STEP(0x114); SCAN_STEP(0x118);
#undef SCAN_STEP
    const float t0 = readlane_f(v, 15), t1 = readlane_f(v, 31), t2 = readlane_f(v, 47);
    const int row = lane >> 4;
    float r = v; if (row >= 1) r = fmaxf(r, t0); if (row >= 2) r = fmaxf(r, t1); if (row >= 3) r = fmaxf(r, t2);
    return r;
}
__device__ __forceinline__ void st_wt_f32(float* p, float v) { __hip_atomic_store((unsigned*)p, __float_as_uint(v), __ATOMIC_RELAXED, __HIP_MEMORY_SCOPE_AGENT); }

__device__ __forceinline__ void mlstm_stage1(const Args& a, const Frame& F0, int layer) {
    const Frame F = phase_frame(F0);
    const int grp = F.wave >> 2, w4 = F.wave & 3, gt = w4 * 64 + F.lane, lane = F.lane, r32 = lane & 31, hh = lane >> 5;
    LAS unsigned char* gl = F.lds + grp * ML_GRP;
    LAS unsigned char* Kt = gl, * Vt = gl + ML_TILE; LAS float* vec = (LAS float*)(gl + 4 * ML_TILE);
    float* CLOC = (float*)(a.ws + WS_CLOC); float* NLOC = (float*)(a.ws + WS_NLOC); float* STAT = (float*)(a.ws + WS_STAT);
    float* GV = (float*)(a.ws + WS_GV);
    u32x4 kvr[2][2], vvr[2][2]; float gir[2] = {0.f, 0.f}, gfr[2] = {0.f, 0.f};
#pragma unroll
    for (int ps = 0; ps < 2; ++ps) {
        const int u = (F.bid + 256 * ps) * 2 + grp, c = u & 31, bh = u >> 5, b = bh >> 2, h = bh & 3;
        const bf16_t* KT = (const bf16_t*)(a.ws + WS_MKT) + (size_t)bh * 64 * S + c * 64;
        const bf16_t* VT = (const bf16_t*)(a.ws + WS_MVT) + (size_t)bh * 64 * S + c * 64;
#pragma unroll
        for (int i = 0; i < 2; ++i) { const int p = gt + 256 * i, row = p >> 3, pc = p & 7; kvr[ps][i] = *(const u32x4*)(KT + (size_t)row * S + pc * 8); vvr[ps][i] = *(const u32x4*)(VT + (size_t)row * S + pc * 8); }
        if (w4 == 0) { const float* G = (const float*)(a.ws + WS_GATES) + (size_t)(b * S + c * 64 + lane) * 8; gir[ps] = G[h]; gfr[ps] = G[4 + h]; }
    }
#pragma unroll
    for (int ps = 0; ps < 2; ++ps) {
        const int u = (F.bid + 256 * ps) * 2 + grp;
        __syncthreads();
        if (w4 == 0) {
            const float gi = gir[ps], lf = logsigmoidf_(gfr[ps]);
            const float bc = wave_scan_sum(lf, lane), igmb = gi - bc;
            const float gtot = readlane_f(bc, 63);
            const float we = gtot - bc + gi; const float ml = wave_max(we);
            vec[192 + lane] = __expf(we - ml);
            const float pm = wave_scan_max(igmb, lane);
            st_wt_f32(GV + (size_t)u * 192 + lane, bc); st_wt_f32(GV + (size_t)u * 192 + 64 + lane, igmb); st_wt_f32(GV + (size_t)u * 192 + 128 + lane, pm);
            if (lane == 0) { st_wt_f32(STAT + u * 4, gtot); st_wt_f32(STAT + u * 4 + 1, ml); }
        }
        __syncthreads();
#pragma unroll
        for (int i = 0; i < 2; ++i) {
            const int p = gt + 256 * i, row = p >> 3, pc = p & 7;
            const u32x4 kv = kvr[ps][i], vv = vvr[ps][i];
            float ae[8];
#pragma unroll
            for (int j = 0; j < 8; ++j) ae[j] = vec[192 + unperm_p(pc * 8 + j)];
            u32x4 ko; ko.x = pk2(bflo(kv.x) * ae[0], bfhi(kv.x) * ae[1]); ko.y = pk2(bflo(kv.y) * ae[2], bfhi(kv.y) * ae[3]); ko.z = pk2(bflo(kv.z) * ae[4], bfhi(kv.z) * ae[5]); ko.w = pk2(bflo(kv.w) * ae[6], bfhi(kv.w) * ae[7]);
            *(LAS u32x4*)(Kt + row * ML_STR + pc * 16) = ko; *(LAS u32x4*)(Vt + row * ML_STR + pc * 16) = vv;
        }
        __syncthreads();
        if (w4 == 1) {
            float sum = 0.f;
#pragma unroll
            for (int pc = 0; pc < 8; ++pc) { const u32x4 kv = *(const LAS u32x4*)(Kt + lane * ML_STR + pc * 16);
                sum += (bflo(kv.x) + bfhi(kv.x)) + (bflo(kv.y) + bfhi(kv.y)) + (bflo(kv.z) + bfhi(kv.z)) + (bflo(kv.w) + bfhi(kv.w)); }
            st_wt_f32(NLOC + u * 64 + lane, sum);
        }
        const int eb = w4 >> 1, db = w4 & 1;
        f32x16 acc;
#pragma unroll
        for (int i = 0; i < 16; ++i) acc[i] = 0.f;
#pragma unroll
        for (int ks = 0; ks < 4; ++ks) {
            const bf16x8 af = *(const LAS bf16x8*)(Vt + (eb * 32 + r32) * ML_STR + ks * 32 + hh * 16);
            const bf16x8 bfg = *(const LAS bf16x8*)(Kt + (db * 32 + r32) * ML_STR + ks * 32 + hh * 16);
            acc = __builtin_amdgcn_mfma_f32_32x32x16_bf16(af, bfg, acc, 0, 0, 0);
        }
#pragma unroll
        for (int r = 0; r < 16; ++r) st_wt_f32(CLOC + (size_t)u * 4096 + (eb * 32 + crow(r, hh)) * 64 + db * 32 + r32, acc[r]);
    }
    asm volatile("s_waitcnt vmcnt(0)" ::: "memory");
    if (lane == 0) { __hip_atomic_fetch_add(F.ctl + CW_ML + 64 * (32 * layer + (F.bid >> 4)), 1u, __ATOMIC_RELAXED, __HIP_MEMORY_SCOPE_AGENT);
                     __hip_atomic_fetch_add(F.ctl + CW_ML + 64 * (32 * layer + 16 + (F.bid >> 4)), 1u, __ATOMIC_RELAXED, __HIP_MEMORY_SCOPE_AGENT); }
}
__device__ __forceinline__ void mlstm_scan_wait(const Frame& F, int layer, int bh) {
    if (F.tid == 0) { unsigned spins = 0;
        while (__hip_atomic_load(F.ctl + CW_ML + 64 * (32 * layer + bh), __ATOMIC_RELAXED, __HIP_MEMORY_SCOPE_AGENT) < 128u) { __builtin_amdgcn_s_sleep(2); if (++spins > (1u << 24)) break; }
        __builtin_amdgcn_fence(__ATOMIC_ACQUIRE, "agent"); VM_WAIT(); }
    __syncthreads();
}

__device__ __forceinline__ void mlstm_scan_unit(const Args& a, const Frame& F0, int su) {
    const Frame F = phase_frame(F0);
    const int bh = su >> 3, part = su & 7, idx = part * 512 + F.tid;
    const float* CLOC = (const float*)(a.ws + WS_CLOC); const float* NLOC = (const float*)(a.ws + WS_NLOC); const float* STAT = (const float*)(a.ws + WS_STAT);
    bf16_t* CPREV = (bf16_t*)(a.ws + WS_CPREV); float* NPREV = (float*)(a.ws + WS_NPREV); float* STATW = (float*)(a.ws + WS_STAT);
    float Cst = 0.f, nst = 0.f, mst = 0.f;
    const bool do_n = (part == 0) && (F.tid < 64);
#pragma unroll
    for (int half = 0; half < 2; ++half) {
        float g[16], ml[16], cl[16], nl[16];
#pragma unroll
        for (int c = 0; c < 16; ++c) { const int u = bh * 32 + half * 16 + c;
            g[c] = ld_coherent(STAT + u * 4); ml[c] = ld_coherent(STAT + u * 4 + 1);
            cl[c] = CLOC[(size_t)u * 4096 + idx]; nl[c] = do_n ? NLOC[u * 64 + F.tid] : 0.f; }
#pragma unroll
        for (int c = 0; c < 16; ++c) { const int u = bh * 32 + half * 16 + c;
            CPREV[(size_t)u * 4096 + idx] = (bf16_t)(pk2(Cst, 0.f) & 0xffffu);
            if (do_n) NPREV[u * 64 + F.tid] = nst;
            if (part == 0 && F.tid == 0) STATW[u * 4 + 2] = mst;
            const float mnew = fmaxf(g[c] + mst, ml[c]), aa = expf(g[c] + mst - mnew), bb = expf(ml[c] - mnew);
            Cst = aa * Cst + bb * cl[c]; nst = aa * nst + bb * nl[c]; mst = mnew; }
    }
}

__device__ __forceinline__ void mlstm_stage3_item(const Args& a, const Frame& F0, int item) {
    const Frame F = phase_frame(F0);
    const int grp = F.wave >> 2, w4 = F.wave & 3, gt = w4 * 64 + F.lane, lane = F.lane, r32 = lane & 31, hh = lane >> 5;
    LAS unsigned char* gl = F.lds + grp * ML_GRP;
    LAS unsigned char* Qs = gl, * Ks = gl + ML_TILE, * Vt = gl + 2 * ML_TILE, * Cs = gl + 3 * ML_TILE; LAS float* vec = (LAS float*)(gl + 4 * ML_TILE);
    const float* STAT = (const float*)(a.ws + WS_STAT); const float* GV = (const float*)(a.ws + WS_GV); const float* NPV = (const float*)(a.ws + WS_NPREV);
    u32x4 tq[2], tk[2], tv[2], tc[2]; float g_bc = 0.f, g_ig = 0.f, g_pm = 0.f, g_mp = 0.f, g_np = 0.f;
#define ST3_LOAD(pp) do { const int u_ = (item * 4 + (pp)) * 2 + grp, c_ = u_ & 31, bh_ = u_ >> 5, b_ = bh_ >> 2, h_ = bh_ & 3; \
        const bf16_t* Z_ = (const bf16_t*)(a.ws + WS_Z) + ((size_t)b_ * S + c_ * 64) * ZLD; const bf16_t* VT_ = (const bf16_t*)(a.ws + WS_MVT) + (size_t)bh_ * 64 * S + c_ * 64; \
        const bf16_t* CP_ = (const bf16_t*)(a.ws + WS_CPREV) + (size_t)u_ * 4096; \
        _Pragma("unroll") for (int i_ = 0; i_ < 2; ++i_) { const int p_ = gt + 256 * i_, row_ = p_ >> 3, pc_ = p_ & 7; \
            tq[i_] = *(const u32x4*)(Z_ + (size_t)row_ * ZLD + 512 + h_ * 64 + pc_ * 8); tk[i_] = *(const u32x4*)(Z_ + (size_t)row_ * ZLD + 768 + h_ * 64 + pc_ * 8); \
            tv[i_] = *(const u32x4*)(VT_ + (size_t)row_ * S + pc_ * 8); tc[i_] = *(const u32x4*)(CP_ + row_ * 64 + pc_ * 8); } \
        if (w4 == 0) { g_bc = GV[(size_t)u_ * 192 + lane]; g_ig = GV[(size_t)u_ * 192 + 64 + lane]; g_pm = GV[(size_t)u_ * 192 + 128 + lane]; g_mp = ld_coherent(STAT + u_ * 4 + 2); g_np = NPV[u_ * 64 + lane]; } } while (0)
    ST3_LOAD(0);
    for (int pp = 0; pp < 4; ++pp) {
        const int u = (item * 4 + pp) * 2 + grp, c = u & 31, bh = u >> 5, b = bh >> 2, h = bh & 3;
        __syncthreads();
#pragma unroll
        for (int i = 0; i < 2; ++i) { const int p = gt + 256 * i, row = p >> 3, pc = p & 7;
            *(LAS u32x4*)(Qs + row * ML_STR + pc * 16) = tq[i]; *(LAS u32x4*)(Ks + row * ML_STR + pc * 16) = tk[i];
            *(LAS u32x4*)(Vt + row * ML_STR + pc * 16) = tv[i]; *(LAS u32x4*)(Cs + row * ML_STR + pc * 16) = tc[i]; }
        if (w4 == 0) { const float il = g_bc + g_mp, mj = fmaxf(il, g_bc + g_pm);
            vec[lane] = g_bc; vec[64 + lane] = g_ig; vec[192 + lane] = mj; vec[256 + lane] = expf(il - mj); vec[320 + lane] = g_np; }
        if (pp + 1 < 4) ST3_LOAD(pp + 1);
        __syncthreads();
        const int jb = w4 & 1, eb = w4 >> 1, j = jb * 32 + r32;
        const float mj = vec[192 + j], ainter = vec[256 + j], bj = vec[j] - mj;
        const size_t trow = (size_t)b * S + c * 64 + j;
        const bf16_t* orow = (const bf16_t*)(a.ws + WS_Z) + trow * ZLD + 1024 + h * 64 + eb * 32;
        u32x2 ovr[4];
#pragma unroll
        for (int g = 0; g < 4; ++g) ovr[g] = *(const u32x2*)(orow + 8 * g + 4 * hh);
        f32x16 p0, p1, X;
#pragma unroll
        for (int i = 0; i < 16; ++i) { p0[i] = 0.f; p1[i] = 0.f; X[i] = 0.f; }
        bf16x8 qf[4];
#pragma unroll
        for (int ks = 0; ks < 4; ++ks) qf[ks] = *(const LAS bf16x8*)(Qs + j * ML_STR + ks * 32 + hh * 16);
#pragma unroll
        for (int ks = 0; ks < 4; ++ks) {
            const bf16x8 k0 = *(const LAS bf16x8*)(Ks + r32 * ML_STR + ks * 32 + hh * 16), k1 = *(const LAS bf16x8*)(Ks + (32 + r32) * ML_STR + ks * 32 + hh * 16);
            const bf16x8 cf = *(const LAS bf16x8*)(Cs + (eb * 32 + r32) * ML_STR + ks * 32 + hh * 16);
            p0 = __builtin_amdgcn_mfma_f32_32x32x16_bf16(k0, qf[ks], p0, 0, 0, 0);
            p1 = __builtin_amdgcn_mfma_f32_32x32x16_bf16(k1, qf[ks], p1, 0, 0, 0);
            X = __builtin_amdgcn_mfma_f32_32x32x16_bf16(cf, qf[ks], X, 0, 0, 0);
        }
        float rs = 0.f;
#pragma unroll
        for (int r = 0; r < 16; ++r) {
            const int s0 = crow(r, hh), s1 = 32 + s0;
            const float w0 = (s0 <= j) ? expf(bj + vec[64 + s0]) * 0.125f : 0.f, w1 = (s1 <= j) ? expf(bj + vec[64 + s1]) * 0.125f : 0.f;
            p0[r] *= w0; p1[r] *= w1; rs += p0[r] + p1[r];
        }
        rs = xor32_sum(rs);
        float qn = 0.f;
#pragma unroll
        for (int pc = 0; pc < 4; ++pc) { const u32x4 qv = *(const LAS u32x4*)(Qs + j * ML_STR + (hh * 4 + pc) * 16); const LAS float* nv = vec + 320 + hh * 32 + pc * 8;
            qn += bflo(qv.x) * nv[0] + bfhi(qv.x) * nv[1] + bflo(qv.y) * nv[2] + bfhi(qv.y) * nv[3] + bflo(qv.z) * nv[4] + bfhi(qv.z) * nv[5] + bflo(qv.w) * nv[6] + bfhi(qv.w) * nv[7]; }
        qn = xor32_sum(qn);
        const float den = ainter * qn * 0.125f + rs;
        const float dinv = 1.0f / fmaxf(fabsf(den), expf(-mj));
        f32x16 Y;
#pragma unroll
        for (int i = 0; i < 16; ++i) Y[i] = 0.f;
#pragma unroll
        for (int kbk = 0; kbk < 2; ++kbk)
#pragma unroll
            for (int s2 = 0; s2 < 2; ++s2) {
                u32x4 pw;
                if (kbk == 0) { pw.x = pk2(p0[8 * s2], p0[8 * s2 + 1]); pw.y = pk2(p0[8 * s2 + 2], p0[8 * s2 + 3]); pw.z = pk2(p0[8 * s2 + 4], p0[8 * s2 + 5]); pw.w = pk2(p0[8 * s2 + 6], p0[8 * s2 + 7]); }
                else { pw.x = pk2(p1[8 * s2], p1[8 * s2 + 1]); pw.y = pk2(p1[8 * s2 + 2], p1[8 * s2 + 3]); pw.z = pk2(p1[8 * s2 + 4], p1[8 * s2 + 5]); pw.w = pk2(p1[8 * s2 + 6], p1[8 * s2 + 7]); }
                const bf16x8 af = *(const LAS bf16x8*)(Vt + (eb * 32 + r32) * ML_STR + (kbk * 32 + s2 * 16) * 2 + hh * 16);
                Y = __builtin_amdgcn_mfma_f32_32x32x16_bf16(af, __builtin_bit_cast(bf16x8, pw), Y, 0, 0, 0);
            }
        bf16_t* yrow = (bf16_t*)(a.ws + WS_MIX) + trow * D + 256 + h * 64 + eb * 32;
        const float xs = ainter * 0.125f;
#pragma unroll
        for (int g = 0; g < 4; ++g) {
            const u32x2 ov = ovr[g];
            const float o0 = sigmoidf_(bflo(ov.x)), o1 = sigmoidf_(bfhi(ov.x)), o2 = sigmoidf_(bflo(ov.y)), o3 = sigmoidf_(bfhi(ov.y));
            u32x2 w; w.x = pk2((xs * X[4 * g] + Y[4 * g]) * dinv * o0, (xs * X[4 * g + 1] + Y[4 * g + 1]) * dinv * o1);
            w.y = pk2((xs * X[4 * g + 2] + Y[4 * g + 2]) * dinv * o2, (xs * X[4 * g + 3] + Y[4 * g + 3]) * dinv * o3);
            *(u32x2*)(yrow + 8 * g + 4 * hh) = w;
        }
    }
#undef ST3_LOAD
}

__device__ __forceinline__ void phase_ln1_router(const Args& args, const Frame& F0, int l, const float* xin_skel, bool do_lists) {
    const Frame F = phase_frame(F0);
    bf16_t* PRE = (bf16_t*)(args.ws + WS_PRE); bf16_t* U = (bf16_t*)(args.ws + WS_U);
    int* LIST = (int*)(args.ws + WS_LIST); float* ROUTE = (float*)(args.ws + WS_ROUTE);
    const float* WR = args.in[I_WR]; const float* BR = args.in[I_BR];
    LAS float* wl = (LAS float*)F.lds;
    __syncthreads();
    for (int i = F.tid; i < 1024 * 4; i += NTHREADS) { const int c = i >> 2, q = i & 3; *(LAS f32x4*)(wl + c * 16 + (c >> 2) * 4 + q * 4) = *(const f32x4*)(WR + (size_t)c * 16 + q * 4); }
    __syncthreads();
    LAS unsigned* cntL = (LAS unsigned*)(F.lds + 73728);
    LAS unsigned* recs = cntL + 32;
    if (F.tid < 32) cntL[F.tid] = 0u;
    __syncthreads();
    const int m0 = F.gw * 8, b = m0 >> 11;
    f32x4 pg[4], pb[4], psh[4], psc[4];
#pragma unroll
    for (int j = 0; j < 4; ++j) { const int c = 4 * F.lane + 256 * j;
        pg[j] = *(const f32x4*)(args.in[I_LN1G] + l * D + c); pb[j] = *(const f32x4*)(args.in[I_LN1B] + l * D + c);
        psh[j] = mod4(args, l, b, 3072 + c); psc[j] = mod4(args, l, b, 4096 + c) + 1.0f; }
    u32x2 nxa[4], nxb[4];
#pragma unroll
    for (int j = 0; j < 4; ++j) { nxa[j] = *(const u32x2*)(PRE + (size_t)m0 * D + 4 * F.lane + 256 * j); nxb[j] = *(const u32x2*)(PRE + (size_t)(m0 + 1) * D + 4 * F.lane + 256 * j); }
    for (int it = 0; it < 8; it += 2) {
        const int m = m0 + it;
        f32x4 va[4], vb[4];
#pragma unroll
        for (int j = 0; j < 4; ++j) { va[j] = (f32x4){bflo(nxa[j].x), bfhi(nxa[j].x), bflo(nxa[j].y), bfhi(nxa[j].y)}; vb[j] = (f32x4){bflo(nxb[j].x), bfhi(nxb[j].x), bflo(nxb[j].y), bfhi(nxb[j].y)}; }
        if (it < 6) {
#pragma unroll
            for (int j = 0; j < 4; ++j) { nxa[j] = *(const u32x2*)(PRE + (size_t)(m + 2) * D + 4 * F.lane + 256 * j); nxb[j] = *(const u32x2*)(PRE + (size_t)(m + 3) * D + 4 * F.lane + 256 * j); } }
        float meana, rstda, meanb, rstdb; ln_stats(va, meana, rstda); ln_stats(vb, meanb, rstdb);
#pragma unroll
        for (int j = 0; j < 4; ++j) {
            const int c = 4 * F.lane + 256 * j;
            va[j] = (va[j] - meana) * rstda * pg[j] + pb[j]; vb[j] = (vb[j] - meanb) * rstdb * pg[j] + pb[j];
            st_bf16x4(PRE + (size_t)m * D + c, va[j]); st_bf16x4(PRE + (size_t)(m + 1) * D + c, vb[j]);
        }
        ln_stats(va, meana, rstda); ln_stats(vb, meanb, rstdb);
        float lga[16], lgb[16];
#pragma unroll
        for (int e = 0; e < 16; ++e) { lga[e] = 0.f; lgb[e] = 0.f; }
#pragma unroll
        for (int j = 0; j < 4; ++j) {
            const int c = 4 * F.lane + 256 * j;
            const f32x4 ua = (va[j] - meana) * rstda * psc[j] + psh[j], ub = (vb[j] - meanb) * rstdb * psc[j] + psh[j];
            st_bf16x4(U + (size_t)m * D + c, ua); st_bf16x4(U + (size_t)(m + 1) * D + c, ub);
#pragma unroll
            for (int i = 0; i < 4; ++i) { const LAS f32x4* w = (const LAS f32x4*)(wl + (c + i) * 16 + (c >> 2) * 4);
#pragma unroll
                for (int q = 0; q < 4; ++q) { const f32x4 wv = w[q];
                    lga[4 * q] += ua[i] * wv.x; lga[4 * q + 1] += ua[i] * wv.y; lga[4 * q + 2] += ua[i] * wv.z; lga[4 * q + 3] += ua[i] * wv.w;
                    lgb[4 * q] += ub[i] * wv.x; lgb[4 * q + 1] += ub[i] * wv.y; lgb[4 * q + 2] += ub[i] * wv.z; lgb[4 * q + 3] += ub[i] * wv.w; } }
        }
#pragma unroll
        for (int e = 0; e < 16; ++e) { lga[e] = wave_sum(lga[e]); lgb[e] = wave_sum(lgb[e]); }
        int e0a, e1a, e0b, e1b; float w0a, w1a, w0b, w1b; route_select(lga, BR, e0a, e1a, w0a, w1a); route_select(lgb, BR, e0b, e1b, w0b, w1b);
        if (F.lane == 0 && do_lists) {
            ROUTE[m * 2] = w0a; ROUTE[m * 2 + 1] = w1a; ROUTE[m * 2 + 2] = w0b; ROUTE[m * 2 + 3] = w1b;
            const unsigned r0 = __hip_atomic_fetch_add(cntL + e0a, 1u, __ATOMIC_RELAXED, __HIP_MEMORY_SCOPE_WORKGROUP);
            const unsigned r1 = __hip_atomic_fetch_add(cntL + e1a, 1u, __ATOMIC_RELAXED, __HIP_MEMORY_SCOPE_WORKGROUP);
            const unsigned r2 = __hip_atomic_fetch_add(cntL + e0b, 1u, __ATOMIC_RELAXED, __HIP_MEMORY_SCOPE_WORKGROUP);
            const unsigned r3 = __hip_atomic_fetch_add(cntL + e1b, 1u, __ATOMIC_RELAXED, __HIP_MEMORY_SCOPE_WORKGROUP);
            recs[(F.wave * 8 + it) * 2] = ((unsigned)e0a << 24) | r0; recs[(F.wave * 8 + it) * 2 + 1] = ((unsigned)e1a << 24) | r1;
            recs[(F.wave * 8 + it + 1) * 2] = ((unsigned)e0b << 24) | r2; recs[(F.wave * 8 + it + 1) * 2 + 1] = ((unsigned)e1b << 24) | r3;
        }
    }
    if (do_lists) {
        __syncthreads();
        if (F.tid < 16) cntL[16 + F.tid] = atomicAdd(F.ctl + CW_CNT + 64 * (16 * l + F.tid), cntL[F.tid]);
        __syncthreads();
        if (F.tid < 64) { const int w = F.tid >> 3, i = F.tid & 7; const int m = (F.bid * NWAVES + w) * 8 + i;
            if (m < T) {
#pragma unroll
                for (int k = 0; k < 2; ++k) { const unsigned rc = recs[F.tid * 2 + k]; const int e = (int)(rc >> 24); LIST[e * T + cntL[16 + e] + (rc & 0xffffffu)] = m * 2 + k; } } }
    }
}
__device__ __forceinline__ void phase_ln2_final(const Args& args, const Frame& F0, int l, bool with_moe) {
    const Frame F = phase_frame(F0);
    const bf16_t* X1 = (const bf16_t*)(args.ws + WS_PRE); const bf16_t* YB = (const bf16_t*)(args.ws + WS_YB); bf16_t* U = (bf16_t*)(args.ws + WS_U);
    const int m0 = F.gw * 8, b = m0 >> 11;
    f32x4 pg2[4], pg[4], pb[4], psh[4], psc[4];
#pragma unroll
    for (int j = 0; j < 4; ++j) { const int c = 4 * F.lane + 256 * j;
        pg2[j] = mod4(args, l, b, 5120 + c); pg[j] = *(const f32x4*)(args.in[I_LN2G] + l * D + c); pb[j] = *(const f32x4*)(args.in[I_LN2B] + l * D + c);
        if (l + 1 < DEPTH) { psh[j] = mod4(args, l + 1, b, c); psc[j] = mod4(args, l + 1, b, 1024 + c) + 1.0f; } else { psh[j] = F4ZERO; psc[j] = F4ZERO; } }
    u32x2 nx[4], ny0[4], ny1[4];
#define P9_LOAD(mm) do { _Pragma("unroll") for (int j = 0; j < 4; ++j) { const int c = 4 * F.lane + 256 * j; nx[j] = *(const u32x2*)(X1 + (size_t)(mm) * D + c); \
        ny0[j] = *(const u32x2*)(YB + (size_t)(2 * (mm)) * D + c); ny1[j] = *(const u32x2*)(YB + (size_t)(2 * (mm) + 1) * D + c); } } while (0)
    P9_LOAD(m0);
    for (int it = 0; it < 8; ++it) {
        const int m = m0 + it;
        f32x4 v[4];
#pragma unroll
        for (int j = 0; j < 4; ++j) {
            const f32x4 x1 = (f32x4){bflo(nx[j].x), bfhi(nx[j].x), bflo(nx[j].y), bfhi(nx[j].y)};
            const f32x4 y = (f32x4){bflo(ny0[j].x) + bflo(ny1[j].x), bfhi(ny0[j].x) + bfhi(ny1[j].x), bflo(ny0[j].y) + bflo(ny1[j].y), bfhi(ny0[j].y) + bfhi(ny1[j].y)};
            v[j] = x1 * DN_ALPHA + (with_moe ? pg2[j] * y : F4ZERO);
        }
        if (it < 7) P9_LOAD(m + 1);
        float mean, rstd; ln_stats(v, mean, rstd);
#pragma unroll
        for (int j = 0; j < 4; ++j) {
            const int c = 4 * F.lane + 256 * j;
            v[j] = (v[j] - mean) * rstd * pg[j] + pb[j];
            if (MK_STAMP >= 0 && l + 1 == DEPTH && m == 0 && j == 0 && F.lane == 0) { const unsigned long long d_ = __hip_atomic_load((unsigned long long*)(F.ctl + CW_STAMP) + 1, __ATOMIC_RELAXED, __HIP_MEMORY_SCOPE_AGENT); v[j].x = (float)d_ * 0.01f; }
            if (l + 1 < DEPTH) st_bf16x4((bf16_t*)args.out + (size_t)m * D + c, v[j]); else *(f32x4*)(args.out + (size_t)m * D + c) = v[j];
        }
        if (l + 1 < DEPTH) {
            ln_stats(v, mean, rstd);
#pragma unroll
            for (int j = 0; j < 4; ++j) st_bf16x4(U + (size_t)m * D + 4 * F.lane + 256 * j, (v[j] - mean) * rstd * psc[j] + psh[j]);
        }
    }
#undef P9_LOAD
}

#define GRID_BAR() xcd_barrier(bar)
#define STAMP_T0(k) do { if (MK_STAMP == (k) && F.bid == 0 && F.wave == 0 && lane_id() == 0) { unsigned long long* st_ = (unsigned long long*)(F.ctl + CW_STAMP); st_[0] = __builtin_amdgcn_s_memrealtime(); } } while (0)
#define STAMP_T1(k) do { if (MK_STAMP == (k) && F.bid == 0 && F.wave == 0 && lane_id() == 0) { unsigned long long* st_ = (unsigned long long*)(F.ctl + CW_STAMP); st_[1] = __builtin_amdgcn_s_memrealtime() - st_[0]; } } while (0)
#define STAMP(k) do { STAMP_T1((k) - 1); STAMP_T0(k); } while (0)
template <int l>
__device__ __forceinline__ void layer_body(const Frame& F, const XcdBarrier& bar, volatile LAS unsigned* MISC) {
        STAMP_T0(l * 10 + 1);
#if MK_MIXER
        REPS(1) {
        {
            const Args args = load_args();
            pg8::Gemm g{(const bf16_t*)(args.ws + WS_U), (const bf16_t*)(args.ws + WS_BTIN), D, D, nullptr};
            pg8::StaticOrder So; const Frame Fp = phase_frame(F); So.init(T, NIN, D, D, Fp.G, Fp.bid); EpiIn E{args.ws, args.in[I_BI], args.in[I_BF], l};
            pg8::gemm_phase<EpiIn, pg8::StaticOrder, false>(F.lds, Fp.wave, g, So, E);
        }
        GRID_BAR();
        }
        STAMP(l * 10 + 2);
        REPS(2) {
#if MK_MIXER >= 3
        { const Args args = load_args(); mlstm_stage1(args, F, l); }
#endif
        {
            const Args args = load_args();
            __syncthreads();
            pg8::Gemm g{(const bf16_t*)(args.ws + WS_Z), (const bf16_t*)(args.ws + WS_BTUP), ZLD, 384, nullptr};
            pg8::StaticOrder So; const Frame Fp = phase_frame(F); So.init(T, 1024, ZLD, 384, Fp.G, Fp.bid); EpiUp E{args.ws, l};
            pg8::gemm_phase<EpiUp, pg8::StaticOrder, false>(F.lds, Fp.wave, g, So, E);
        }
#if MK_MIXER >= 3
        { const Args args = load_args(); const Frame Fp = phase_frame(F);
          for (int su = Fp.bid; su < 256; su += Fp.G) { mlstm_scan_wait(Fp, l, su >> 3); mlstm_scan_unit(args, Fp, su); } }
#endif
        GRID_BAR();
        }
        STAMP(l * 10 + 3);
        REPS(3) {
        {
            const Args args = load_args(); const Frame Fp = phase_frame(F);
            const int xcc = (int)(bar.x & 7u);
            bool own_live = true;
            for (;;) { const int qj = queue_next_xcd(Fp, l * 2 + rep_, xcc, 96, own_live); if (qj < 0) break;
                const int q = qj >> 16, j = qj & 0xffff;
                const bool is_ml = (j >= 32 && j < 48), is_cv = (j >= 80); const int ja = (j < 32) ? j : j - 16;
                if (rep_ && MK_PROBE_KIND) { const int kind = (is_ml || is_cv) ? 3 : ((ja & 4) ? 2 : 1); if (kind != MK_PROBE_KIND) continue; }
                if (is_ml) { const int bh = ((j - 32) >> 2) * 8 + q; mlstm_stage3_item(args, Fp, bh * 4 + ((j - 32) & 3)); }
                else if (is_cv) conv_item(args, Fp, l, (j - 80) * 8 + q);
                else { const int qb = 7 - (ja >> 3), bh = (ja & 3) * 8 + q;
                    if (ja & 4) mla_unit(args, Fp, bh, qb); else diff_unit(args, Fp, l, bh, qb); }
            }
        }
        GRID_BAR();
        }
        STAMP(l * 10 + 4);
        STAMP(l * 10 + 5);
        REPS(5) {
        {
            const Args args = load_args(); const bf16_t* xin = (const bf16_t*)args.out;
            pg8::Gemm g{(const bf16_t*)(args.ws + WS_MIX), (const bf16_t*)(args.ws + WS_BTOUT), D, D, nullptr};
            pg8::StaticOrder So; const Frame Fp = phase_frame(F); So.init(T, D, D, D, Fp.G, Fp.bid); EpiOut E{args.ws, args.in[I_BADA], xin, l};
            pg8::gemm_phase<EpiOut, pg8::StaticOrder, false>(F.lds, Fp.wave, g, So, E);
        }
        GRID_BAR();
        }
#endif
        STAMP(l * 10 + 6);
        { const Args args = load_args();
          phase_ln1_router(args, F, l, nullptr, true);
          REPS(6) { if (rep_) { GRID_BAR(); phase_ln1_router(args, F, l, nullptr, false); } } }
        GRID_BAR();
        STAMP(l * 10 + 7);
        REPS(7) {
        moe_tile_table(F, l);
        {
            const Args args = load_args();
            pg8::Gemm g{(const bf16_t*)(args.ws + WS_U), (const bf16_t*)(args.ws + ((l & 1) ? WS_BT13B : WS_BT13)), D, D, (const int*)(args.ws + WS_LIST)};
            const Frame Fp = phase_frame(F); unsigned* rdy = (unsigned*)(F.ctl + CW_MOE + 64 * 160 * (2 * l + rep_));
            MoeOrder So{MISC, 2, 1, (unsigned*)(F.ctl + CW_MQ + 64 * 8 * (4 * l + 2 * rep_)), Fp.wave, rdy, (int)(bar.x & 7u), true}; EpiMoe1 E{args.ws, rdy};
            pg8::gemm_phase<EpiMoe1, MoeOrder, true>(F.lds, Fp.wave, g, So, E);
        }
        if (!(rep_ && MK_PROBE_KIND == 1)) {
            const Args args = load_args();
            pg8::Gemm g{(const bf16_t*)(args.ws + WS_H), (const bf16_t*)(args.ws + WS_BT2), DEXP, DEXP, nullptr};
            const Frame Fp = phase_frame(F); unsigned* rdy = (unsigned*)(F.ctl + CW_MOE + 64 * 160 * (2 * l + rep_));
            MoeOrder So{MISC, 4, 2, (unsigned*)(F.ctl + CW_MQ + 64 * 8 * (4 * l + 2 * rep_ + 1)), Fp.wave, rdy, (int)(bar.x & 7u), true}; EpiMoe2 E{args.ws};
            pg8::gemm_phase<EpiMoe2, MoeOrder, false>(F.lds, Fp.wave, g, So, E);
        }
        if (l + 1 < DEPTH && rep_ == 0) { const Args args = load_args(); __syncthreads(); convert_weights(args, F, l + 1, 1); }
        GRID_BAR();
        }
        STAMP(l * 10 + 9);
        REPS(9) { const Args args = load_args(); if (rep_) { GRID_BAR(); phase_ln2_final(args, F, l, true); } }
        { const Args args = load_args();
          phase_ln2_final(args, F, l, true);
          if (l + 1 < DEPTH) { __syncthreads(); convert_weights(args, F, l + 1, 2); } }
        if (l + 1 < DEPTH) { GRID_BAR(); STAMP_T1(l * 10 + 9); }
}

__global__ void __launch_bounds__(NTHREADS, 2) mk_fwd(Args args_unused) {
    extern __shared__ __attribute__((aligned(16))) unsigned char lds_raw[];
    Frame F;
    F.lds = (LAS unsigned char*)lds_raw;
    { const Args a0 = load_args(); F.ws = a0.ws; F.ctl = (unsigned*)(a0.ws + WS_CTL); }
    F.wave = __builtin_amdgcn_readfirstlane((int)threadIdx.x >> 6); F.lane = lane_id(); F.tid = F.wave * 64 + F.lane;
    F.bid = blockIdx.x; F.G = gridDim.x; F.gw = F.bid * NWAVES + F.wave; F.NGW = F.G * NWAVES;
    volatile LAS unsigned* MISC = (volatile LAS unsigned*)(F.lds + LDS_MISC);
    for (int u = F.tid; u < (LDS_BYTES - LDS_MISC) / 4; u += NTHREADS) ((LAS unsigned*)(F.lds + LDS_MISC))[u] = 0u;
    __syncthreads();
    XcdBarrier bar = xcd_barrier_post(F.ctl + CW_BAR, MISC + 8, F.wave);
    STAMP_T0(100);

    { const Args args = load_args();
      REPS(10) { convert_weights(args, F, 0, 0); __syncthreads(); }
      REPS(11) { mod_gemv(args, F); }
      rope_table(args, F); }
    GRID_BAR();
    STAMP_T1(100); STAMP_T0(101);
    REPS(12) {
        const Args args = load_args(); const Frame Fp = phase_frame(F);
        bf16_t* U = (bf16_t*)(args.ws + WS_U);
        for (int m = Fp.gw; m < T; m += Fp.NGW) {
            const f32x4* xr = (const f32x4*)(args.in[I_X] + (size_t)m * D) + Fp.lane;
            f32x4 v[4];
#pragma unroll
            for (int j = 0; j < 4; ++j) { v[j] = xr[64 * j]; st_bf16x4((bf16_t*)args.out + (size_t)m * D + 4 * Fp.lane + 256 * j, v[j]); }
            lnmod_row(args, Fp, 0, 0, v, m >> 11, U + (size_t)m * D);
        }
    }
    GRID_BAR();

    STAMP_T1(101);
    layer_body<0>(F, bar, MISC);
    layer_body<1>(F, bar, MISC);
}

extern "C" void kernel_launch(void* const* d_in, const int* in_sizes, int n_in, void* d_out, int out_size, void* d_ws, size_t ws_size, hipStream_t stream) {
    static int grid = 0;
    if (grid == 0) {
        if (n_in != 27 || out_size != T * D || ws_size < WS_END) { fprintf(stderr, "kernel_launch: unexpected problem (n_in %d out %d ws %zu)\n", n_in, out_size, ws_size); grid = -1; return; }
        int dev = 0, cus = 0, per_cu = 0;
        if (hipGetDevice(&dev) != hipSuccess || hipDeviceGetAttribute(&cus, hipDeviceAttributeMultiprocessorCount, dev) != hipSuccess) { grid = -1; return; }
        if (hipFuncSetAttribute((const void*)mk_fwd, hipFuncAttributeMaxDynamicSharedMemorySize, LDS_BYTES) != hipSuccess) { fprintf(stderr, "kernel_launch: hipFuncSetAttribute failed\n"); grid = -1; return; }
        if (hipOccupancyMaxActiveBlocksPerMultiprocessor(&per_cu, (const void*)mk_fwd, NTHREADS, LDS_BYTES) != hipSuccess || per_cu < 1)
            fprintf(stderr, "kernel_launch: occupancy query reports %d per CU\n", per_cu);
        (void)hipGetLastError();
        grid = cus;
    }
    if (grid < 0) return;
    (void)hipMemsetAsync((char*)d_ws + WS_CTL, 0, CTL_ZERO_BYTES, stream);
    Args a{};
    for (int i = 0; i < 27; ++i) a.in[i] = (const float*)d_in[i];
    a.out = (float*)d_out; a.ws = (unsigned char*)d_ws;
    hipLaunchKernelGGL(mk_fwd, dim3(grid), dim3(NTHREADS), LDS_BYTES, stream, a);
}
```

```cpp
#include <hip/hip_runtime.h>
#include <cstdio>
#include <cstdint>

#define GAS __attribute__((address_space(1)))
#define LAS __attribute__((address_space(3)))
typedef unsigned short bf16_t;
typedef short bf16x8 __attribute__((ext_vector_type(8)));
typedef short s16x4 __attribute__((ext_vector_type(4)));
typedef float f32x2 __attribute__((ext_vector_type(2)));
typedef float f32x4 __attribute__((ext_vector_type(4)));
typedef float f32x16 __attribute__((ext_vector_type(16)));
typedef unsigned u32x2 __attribute__((ext_vector_type(2)));
typedef unsigned u32x4 __attribute__((ext_vector_type(4)));
typedef __bf16 bf16x2_t __attribute__((ext_vector_type(2)));

#ifndef MK_STAMP
#define MK_STAMP (-1)
#endif
#ifndef MK_PROBE_PHASE
#define MK_PROBE_PHASE (-1)
#endif
#ifndef MK_PROBE_KIND
#define MK_PROBE_KIND 0
#endif
#ifndef MK_PROBE_N
#define MK_PROBE_N 1
#endif
#define REPS(k) for (int rep_ = 0; rep_ < ((MK_PROBE_PHASE == (k)) ? MK_PROBE_N + 1 : 1); ++rep_)
#ifndef MK_MIXER
#define MK_MIXER 3
#endif
constexpr int NB = 8, S = 2048, D = 1024, T = NB * S, DEPTH = 2;
constexpr int NWAVES = 8, NTHREADS = NWAVES * 64;
constexpr int NIN = 3072;
constexpr int ZLD = 2048;
constexpr int WIN_COLS = 2920;
constexpr int NEXP = 16, DEXP = 256;
constexpr float LN_EPS = 1e-5f, RMS_EPS = 1e-6f;
constexpr float DN_ALPHA = 1.4142135623730951f;
constexpr float LOG2E = 1.4426950408889634f;

constexpr size_t MiB = 1u << 20;
constexpr size_t WS_CTL = 0, CTL_ZERO_BYTES = 1 * MiB;
constexpr int CW_BAR = 4096;
constexpr int CW_Q = 8192;
constexpr int CW_ML = 131072;
constexpr int CW_MOE = 147456;
constexpr int CW_CQ = 200704;
constexpr int CW_MQ = 196608;
constexpr int CW_STAMP = 139264;
constexpr int CW_CNT = 12288;
constexpr size_t CTL_MOD = 64 * 1024;
constexpr size_t WS_BTIN = 2 * MiB, WS_BTUP = 8 * MiB, WS_BTOUT = 9 * MiB, WS_BT13 = 11 * MiB, WS_BT2 = 27 * MiB;
constexpr size_t WS_U = 35 * MiB;
constexpr size_t WS_CLOC = 35 * MiB, WS_CPREV = 51 * MiB, WS_NLOC = 59 * MiB, WS_NPREV = 59 * MiB + 512 * 1024, WS_STAT = 60 * MiB, WS_GV = 60 * MiB + 64 * 1024;
constexpr size_t WS_MIX = 67 * MiB, WS_H = 67 * MiB;
constexpr size_t WS_Z = 99 * MiB, WS_PRE = 99 * MiB;
constexpr size_t WS_QM = 163 * MiB, WS_KM = 175 * MiB, WS_VTM = 187 * MiB, WS_QD = 195 * MiB, WS_KD = 203 * MiB, WS_DVT = 211 * MiB, WS_MKT = 219 * MiB, WS_MVT = 227 * MiB;
constexpr size_t WS_YB = 163 * MiB;
constexpr size_t WS_ROPE = 235 * MiB, WS_GATES = 235 * MiB + 512 * 1024, WS_ROUTE = 236 * MiB, WS_LIST = 237 * MiB;
constexpr size_t WS_RSP = 238 * MiB;
constexpr size_t WS_END = 239 * MiB;

constexpr int LDS_BYTES = 147456;
constexpr int LDS_MISC = 139264;

__device__ __forceinline__ unsigned pk2(float lo, float hi) { f32x2 v = {lo, hi}; bf16x2_t b = __builtin_convertvector(v, bf16x2_t); return __builtin_bit_cast(unsigned, b); }
__device__ __forceinline__ void st_bf16x4(bf16_t* p, f32x4 v) { u32x2 o; o.x = pk2(v.x, v.y); o.y = pk2(v.z, v.w); *(u32x2*)p = o; }
__device__ __forceinline__ int colj(int lane, int j) { return 8 * lane + 512 * (j >> 1) + 4 * (j & 1); }
__device__ __forceinline__ void st_bf16x8(bf16_t* p, f32x4 a, f32x4 b) { u32x4 o; o.x = pk2(a.x, a.y); o.y = pk2(a.z, a.w); o.z = pk2(b.x, b.y); o.w = pk2(b.z, b.w); *(u32x4*)p = o; }
__device__ __forceinline__ void st_bf16x8_nt(bf16_t* p, f32x4 a, f32x4 b) { u32x4 o; o.x = pk2(a.x, a.y); o.y = pk2(a.z, a.w); o.z = pk2(b.x, b.y); o.w = pk2(b.z, b.w); __builtin_nontemporal_store(o, (u32x4*)p); }
__device__ __forceinline__ void ld_bf16x8_nt(const bf16_t* p, u32x2& lo, u32x2& hi) { const u32x4 t = __builtin_nontemporal_load((const u32x4*)p); lo.x = t.x; lo.y = t.y; hi.x = t.z; hi.y = t.w; }
__device__ __forceinline__ void st_bf16x4_nt(bf16_t* p, f32x4 v) { u32x2 o; o.x = pk2(v.x, v.y); o.y = pk2(v.z, v.w); __builtin_nontemporal_store(o, (u32x2*)p); }
__device__ __forceinline__ float bf2f(unsigned short u) { return __uint_as_float(((unsigned)u) << 16); }
__device__ __forceinline__ float bflo(unsigned w) { return __uint_as_float(w << 16); }
__device__ __forceinline__ float bfhi(unsigned w) { return __uint_as_float(w & 0xffff0000u); }
template <int M> __device__ __forceinline__ float swz_xor(float v) { return __int_as_float(__builtin_amdgcn_ds_swizzle(__float_as_int(v), (M << 10) | 0x1f)); }
__device__ __forceinline__ void xor32_pair(float v, float& lo, float& hi) { auto rr = __builtin_amdgcn_permlane32_swap(__float_as_uint(v), __float_as_uint(v), false, false); lo = __uint_as_float(rr[0]); hi = __uint_as_float(rr[1]); }
__device__ __forceinline__ float xor32_sum(float v) { float a, b; xor32_pair(v, a, b); return a + b; }
__device__ __forceinline__ float xor32_max(float v) { float a, b; xor32_pair(v, a, b); return fmaxf(a, b); }
template <int CTRL> __device__ __forceinline__ float dppx(float v) { return __int_as_float(__builtin_amdgcn_update_dpp(0, __float_as_int(v), CTRL, 0xf, 0xf, true)); }
__device__ __forceinline__ void xor16_pair(float v, float& lo, float& hi) { auto rr = __builtin_amdgcn_permlane16_swap(__float_as_uint(v), __float_as_uint(v), false, false); lo = __uint_as_float(rr[0]); hi = __uint_as_float(rr[1]); }
__device__ __forceinline__ float xor16_sum(float v) { float a, b; xor16_pair(v, a, b); return a + b; }
__device__ __forceinline__ float wave_sum(float v) {
    v += dppx<0xB1>(v); v += dppx<0x4E>(v); v += dppx<0x141>(v); v += dppx<0x140>(v);
    v = xor16_sum(v); return xor32_sum(v);
}
__device__ __forceinline__ float wave_max(float v) {
    v = fmaxf(v, dppx<0xB1>(v)); v = fmaxf(v, dppx<0x4E>(v)); v = fmaxf(v, dppx<0x141>(v)); v = fmaxf(v, dppx<0x140>(v));
    { float a, b; xor16_pair(v, a, b); v = fmaxf(a, b); } return xor32_max(v);
}
__device__ __forceinline__ float ld_coherent(const float* p) { return __hip_atomic_load(p, __ATOMIC_RELAXED, __HIP_MEMORY_SCOPE_AGENT); }
__device__ __forceinline__ float sigmoidf_(float x) { return __builtin_amdgcn_rcpf(1.0f + __expf(-x)); }
__device__ __forceinline__ float siluf_(float x) { return x / (1.0f + __expf(-x)); }
__device__ __forceinline__ int lane_id();
#define LAUNDER(x) asm volatile("" : "+v"(x))
#define LAUNDER_S(x) asm volatile("" : "+s"(x))
__device__ __forceinline__ f32x4 ld_bf16x4(const bf16_t* p) { const u32x2 w = *(const u32x2*)p; return (f32x4){__uint_as_float(w.x << 16), __uint_as_float(w.x & 0xffff0000u), __uint_as_float(w.y << 16), __uint_as_float(w.y & 0xffff0000u)}; }
#define LDS_WAIT() asm volatile("s_waitcnt lgkmcnt(0)" ::: "memory")
#define VM_WAIT() asm volatile("s_waitcnt vmcnt(0)" ::: "memory")

#define XB_TMO      128
#define XB_XCNT(j)  (256  + 64 * (j))
#define XB_XSUB(j)  (1280 + 64 * (j))
#define XB_XGEN(j)  (2304 + 64 * (j))
#define XB_TOP      3328
#define XB_TOPGEN   3392
#define XCD_BAR_WORDS 3456
#define XB_SPIN_CAP (1u << 22)
__device__ __forceinline__ unsigned xb_ld(unsigned* p)              { return __hip_atomic_load(p, __ATOMIC_RELAXED, __HIP_MEMORY_SCOPE_AGENT); }
__device__ __forceinline__ unsigned xb_add(unsigned* p, unsigned v) { return __hip_atomic_fetch_add(p, v, __ATOMIC_RELAXED, __HIP_MEMORY_SCOPE_AGENT); }
__device__ __forceinline__ unsigned xb_xcc_id() { return (unsigned)__builtin_amdgcn_s_getreg((3 << 11) | 20) & 0xFu; }
#define XB_SPIN(cond, bar) do { unsigned _sp = 0; while (cond) { __builtin_amdgcn_s_sleep(1); \
    if ((++_sp & 255u) == 0u) { if (xb_ld(&(bar)[XB_TMO])) break; if (_sp > XB_SPIN_CAP) { atomicAdd(&(bar)[XB_TMO], 1u); break; } } } } while (0)
struct XcdBarrier { unsigned* bar; unsigned x; volatile LAS unsigned* st; int wave; };
__device__ __forceinline__ int lane_id_() { int l; asm volatile("v_mbcnt_lo_u32_b32 %0, -1, 0\n\tv_mbcnt_hi_u32_b32 %0, -1, %0" : "=v"(l)); return l; }
__device__ __forceinline__ XcdBarrier xcd_barrier_post(unsigned* bar, volatile LAS unsigned* st, int wave) {
    XcdBarrier b; b.bar = bar; b.x = xb_xcc_id(); b.st = st; b.wave = wave;
    if (wave == 0 && lane_id_() == 0) (void)xb_add(&bar[XB_XCNT(b.x)], 1u);
    return b;
}
__device__ __forceinline__ void xcd_barrier_complete(unsigned* bar, unsigned x, unsigned& nloc, unsigned& nx) {
    const unsigned G = gridDim.x * gridDim.y * gridDim.z;
    unsigned sum, cnt, mine, sp = 0u;
    for (;;) {
        sum = 0u; cnt = 0u; mine = 0u;
#pragma unroll
        for (unsigned j = 0; j < 16; ++j) { const unsigned c = xb_ld(&bar[XB_XCNT(j)]); sum += c; cnt += (c > 0u) ? 1u : 0u; mine = (j == x) ? c : mine; }
        if (sum == G) break;
        __builtin_amdgcn_s_sleep(1);
        if ((++sp & 255u) == 0u) { if (xb_ld(&bar[XB_TMO])) break; if (sp > XB_SPIN_CAP) { atomicAdd(&bar[XB_TMO], 1u); break; } }
    }
    nloc = mine > 0u ? mine : 1u; nx = cnt > 0u ? cnt : 1u;
}
__device__ __forceinline__ void xcd_barrier(const XcdBarrier& b) {
    asm volatile("s_waitcnt vmcnt(0)" ::: "memory");
    __syncthreads();
    if (b.wave == 0 && lane_id_() == 0) {
        unsigned* bar = b.bar; asm volatile("" : "+s"(bar));
        __builtin_amdgcn_s_waitcnt(0);
        unsigned nloc = b.st[0], nx = b.st[1];
        unsigned bx = b.x; asm volatile("" : "+s"(bx));
        if (nloc == 0u) { xcd_barrier_complete(bar, bx, nloc, nx); b.st[0] = nloc; b.st[1] = nx; }
        const unsigned old = xb_add(&bar[XB_XSUB(bx)], 1u);
        const unsigned gen = old / nloc;
        if (old + 1u == (gen + 1u) * nloc) {
            __builtin_amdgcn_fence(__ATOMIC_RELEASE, "agent");
            asm volatile("s_waitcnt vmcnt(0)" ::: "memory");
            const unsigned og = xb_add(&bar[XB_TOP], 1u);
            const unsigned tg = og / nx;
            if (og + 1u == (tg + 1u) * nx) xb_add(&bar[XB_TOPGEN], 1u);
            else XB_SPIN(xb_ld(&bar[XB_TOPGEN]) == tg, bar);
            __builtin_amdgcn_fence(__ATOMIC_ACQUIRE, "agent");
            xb_add(&bar[XB_XGEN(bx)], 1u);
            asm volatile("s_waitcnt vmcnt(0)" ::: "memory");
        } else {
            XB_SPIN(xb_ld(&bar[XB_XGEN(bx)]) == gen, bar);
            __builtin_amdgcn_fence(__ATOMIC_ACQUIRE, "agent");
            asm volatile("s_waitcnt vmcnt(0)" ::: "memory");
        }
    }
    __syncthreads();
}

struct Args { const float* in[27]; float* out; unsigned char* ws; int pad0, pad1; };
enum { I_X = 0, I_C, I_WADA, I_BADA, I_WIN, I_GQ, I_GKV, I_WUQ, I_WUKV, I_BI, I_BF, I_SCW, I_LQ1, I_LK1, I_LQ2, I_LK2, I_DFG, I_WOUT, I_LN1G, I_LN1B,
       I_WR, I_BR, I_W1, I_W3, I_W2, I_LN2G, I_LN2B };

struct Frame {
    LAS unsigned char* lds;
    unsigned char* ws;
    unsigned* ctl;
    int tid, lane, wave, bid, G, gw, NGW;
};

__device__ __forceinline__ int lane_id() { return lane_id_(); }
__device__ __forceinline__ Args load_args() {
    typedef const volatile __attribute__((address_space(4))) unsigned long long* kptr_t;
    kptr_t p = (kptr_t)__builtin_amdgcn_kernarg_segment_ptr();
    Args a;
#pragma unroll
    for (int i = 0; i < 27; ++i) a.in[i] = (const float*)(const GAS float*)p[i];
    a.out = (float*)(GAS float*)p[27]; a.ws = (unsigned char*)(GAS unsigned char*)p[28]; a.pad0 = 0; a.pad1 = 0;
    return a;
}
__device__ __forceinline__ Frame phase_frame(const Frame& F0) { Frame F = F0; LAUNDER_S(F.wave); LAUNDER_S(F.bid); LAUNDER_S(F.G); F.gw = F.bid * NWAVES + F.wave; F.NGW = F.G * NWAVES; F.lane = lane_id(); LAUNDER(F.lane); F.tid = F.wave * 64 + F.lane; return F; }

__device__ __forceinline__ f32x4 mod4p(const unsigned char* ws, const float* bada, int l, int b, int idx) {
    const float* M = (const float*)(ws + CTL_MOD) + (size_t)(l * 8 + b) * 6144 + idx;
    const float* Bv = bada + (size_t)l * 6144 + idx;
    return *(const f32x4*)M + *(const f32x4*)Bv;
}
__device__ __forceinline__ f32x4 mod4(const Args& a, int l, int b, int idx) { return mod4p(a.ws, a.in[I_BADA], l, b, idx); }

__device__ __forceinline__ void ln_stats(const f32x4 (&v)[4], float& mean, float& rstd) {
    float s = 0.f;
#pragma unroll
    for (int j = 0; j < 4; ++j) s += (v[j].x + v[j].y) + (v[j].z + v[j].w);
    mean = wave_sum(s) * (1.f / D);
    float s2 = 0.f;
#pragma unroll
    for (int j = 0; j < 4; ++j) { const f32x4 d = v[j] - mean; s2 += (d.x * d.x + d.y * d.y) + (d.z * d.z + d.w * d.w); }
    rstd = __builtin_amdgcn_rsqf(wave_sum(s2) * (1.f / D) + LN_EPS);
}

__device__ __forceinline__ void lnmod_row(const Args& a, const Frame& F, int l, int which  , const f32x4 (&v)[4], int b, bf16_t* urow) {
    float mean, rstd; ln_stats(v, mean, rstd);
    f32x4 u[4];
#pragma unroll
    for (int j = 0; j < 4; ++j) {
        const int c = colj(F.lane, j);
        const f32x4 sh = mod4(a, l, b, which * 3072 + c), sc = mod4(a, l, b, which * 3072 + 1024 + c);
        u[j] = (v[j] - mean) * rstd * (sc + 1.0f) + sh;
    }
    st_bf16x8(urow + colj(F.lane, 0), u[0], u[1]); st_bf16x8(urow + colj(F.lane, 2), u[2], u[3]);
}

template <class SrcF>
__device__ __forceinline__ void transpose_item(const SrcF& src, bf16_t* dst, int Kd, int k0, int n0, LAS float* scr, int lane) {
    const int nl = 4 * (lane & 15), kl = lane >> 4;
    f32x4 v[16];
#pragma unroll
    for (int i = 0; i < 16; ++i) v[i] = src(k0 + 4 * i + kl, n0 + nl);
#pragma unroll
    for (int i = 0; i < 16; ++i) { LAS float* p = scr + (4 * i + kl) * 65 + nl; p[0] = v[i].x; p[1] = v[i].y; p[2] = v[i].z; p[3] = v[i].w; }
    LDS_WAIT(); asm volatile("" ::: "memory");
    const int c = lane & 7;
#pragma unroll
    for (int j = 0; j < 8; ++j) { const int n = (lane >> 3) + 8 * j; const LAS float* s = scr + (8 * c) * 65 + n;
        u32x4 o; o.x = pk2(s[0 * 65], s[1 * 65]); o.y = pk2(s[2 * 65], s[3 * 65]); o.z = pk2(s[4 * 65], s[5 * 65]); o.w = pk2(s[6 * 65], s[7 * 65]);
        *(u32x4*)(dst + (size_t)(n0 + n) * Kd + k0 + 8 * c) = o; }
    LDS_WAIT(); asm volatile("" ::: "memory");
}

__device__ __forceinline__ int zsrc_col(int n) {
    if (n < 352) return n;
    if (n < 360) return 1120 + (n - 352);
    if (n < 512) return -1;
    if (n < 768) return 352 + (n - 512);
    if (n < 1024) return 608 + (n - 768);
    if (n < 1280) return 864 + (n - 1024);
    if (n < 1536) return 1128 + (n - 1280);
    if (n < 1792) return 1384 + (n - 1536);
    if (n < 2048) return 1640 + (n - 1792);
    if (n < 2304) return 1896 + (n - 2048);
    if (n < 2560) return 2152 + (n - 2304);
    if (n < 2816) return 2408 + (n - 2560);
    return 2664 + (n - 2816);
}
constexpr f32x4 F4ZERO = {0.f, 0.f, 0.f, 0.f};
struct SrcIn { const float* W; __device__ __forceinline__ f32x4 operator()(int k, int n) const { const int c = zsrc_col(n); return c >= 0 ? __builtin_nontemporal_load((const f32x4*)(W + (size_t)k * WIN_COLS + c)) : F4ZERO; } };
struct SrcUp { const float* Wq; const float* Wkv; const float* gq; const float* gkv;
    __device__ __forceinline__ f32x4 operator()(int kw, int n) const {
        const int k = (n < 512) ? kw : kw + 128;
        if (n < 384) { if (k >= 192) return F4ZERO; const int col = (n < 256) ? ((n >> 6) * 96 + (n & 63)) : (((n - 256) >> 5) * 96 + 64 + ((n - 256) & 31)); return *(const f32x4*)(Wq + (size_t)k * 384 + col) * gq[k]; }
        if (n < 512) return F4ZERO;
        if (k < 192 || k >= 320) return F4ZERO;
        const int kk = k - 192; const int m = n - 512; const int col = (m < 256) ? ((m >> 6) * 128 + (m & 63)) : (((m - 256) >> 6) * 128 + 64 + ((m - 256) & 63));
        return *(const f32x4*)(Wkv + (size_t)kk * 512 + col) * gkv[kk];
    } };
struct SrcPlain { const float* W; int N; __device__ __forceinline__ f32x4 operator()(int k, int n) const { return __builtin_nontemporal_load((const f32x4*)(W + (size_t)k * N + n)); } };
struct Src13 { const float* W1; const float* W3;
    __device__ __forceinline__ f32x4 operator()(int k, int j) const { const int t = j >> 8, w = j & 255; return (w < 128) ? __builtin_nontemporal_load((const f32x4*)(W1 + (size_t)k * 256 + t * 128 + w)) : __builtin_nontemporal_load((const f32x4*)(W3 + (size_t)k * 256 + t * 128 + (w - 128))); } };

__device__ __forceinline__ void convert_weights(const Args& a, const Frame& F0, int l, int part) {
    const Frame F = phase_frame(F0);
    LAS float* scr = (LAS float*)(F.lds + F.wave * 16896);
    constexpr int I_IN = (1024 / 64) * (NIN / 64);
    constexpr int I_UP = (256 / 64) * (1024 / 64);
    constexpr int I_OUT = (1024 / 64) * (1024 / 64);
    constexpr int I_13 = NEXP * (1024 / 64) * (512 / 64);
    constexpr int I_2 = NEXP * (256 / 64) * (1024 / 64);
    constexpr int NITEMS = I_IN + I_UP + I_OUT + I_13 + I_2;
    bf16_t* BtIn = (bf16_t*)(a.ws + WS_BTIN); bf16_t* BtUp = (bf16_t*)(a.ws + WS_BTUP); bf16_t* BtOut = (bf16_t*)(a.ws + WS_BTOUT);
    bf16_t* Bt13 = (bf16_t*)(a.ws + WS_BT13); bf16_t* Bt2 = (bf16_t*)(a.ws + WS_BT2);
    constexpr int I_PRE = I_IN + I_UP + I_OUT;
    volatile LAS int* cslot = (volatile LAS int*)(F.lds + LDS_MISC + 64);
    for (int it = F.gw;; ) {
        if (part == 1) {
            __syncthreads(); if (F.tid == 0) *cslot = (int)__hip_atomic_fetch_add(F.ctl + CW_CQ + 64 * l, 1u, __ATOMIC_RELAXED, __HIP_MEMORY_SCOPE_AGENT); __syncthreads();
            const int chunk = __builtin_amdgcn_readfirstlane(*cslot);
            if (I_PRE + chunk * 8 >= NITEMS) break;
            it = I_PRE + chunk * 8 + F.wave;
            if (it >= NITEMS) continue;
        } else if (it >= I_PRE) break;
        int r = it; if (part == 0) it += F.NGW;
        if (r < I_IN) { const int nblk = NIN / 64; SrcIn s{a.in[I_WIN] + (size_t)l * 1024 * WIN_COLS}; transpose_item(s, BtIn, 1024, 64 * (r / nblk), 64 * (r % nblk), scr, F.lane); continue; } r -= I_IN;
        if (r < I_UP) { const int nblk = 1024 / 64; SrcUp s{a.in[I_WUQ] + (size_t)l * 192 * 384, a.in[I_WUKV] + (size_t)l * 128 * 512, a.in[I_GQ] + l * 192, a.in[I_GKV] + l * 128};
            transpose_item(s, BtUp, 256, 64 * (r / nblk), 64 * (r % nblk), scr, F.lane); continue; } r -= I_UP;
        if (r < I_OUT) { const int nblk = 1024 / 64; SrcPlain s{a.in[I_WOUT] + (size_t)l * 1024 * 1024, 1024}; transpose_item(s, BtOut, 1024, 64 * (r / nblk), 64 * (r % nblk), scr, F.lane); continue; } r -= I_OUT;
        if (r < I_13) { const int per = (1024 / 64) * (512 / 64); const int e = r / per, q = r % per; const int nblk = 512 / 64;
            Src13 s{a.in[I_W1] + ((size_t)l * NEXP + e) * 1024 * 256, a.in[I_W3] + ((size_t)l * NEXP + e) * 1024 * 256};
            transpose_item(s, Bt13 + (size_t)e * 512 * 1024, 1024, 64 * (q / nblk), 64 * (q % nblk), scr, F.lane); continue; } r -= I_13;
        { const int per = (256 / 64) * (1024 / 64); const int e = r / per, q = r % per; const int nblk = 1024 / 64;
            SrcPlain s{a.in[I_W2] + ((size_t)l * NEXP + e) * 256 * 1024, 1024};
            transpose_item(s, Bt2 + (size_t)e * 1024 * 256, 256, 64 * (q / nblk), 64 * (q % nblk), scr, F.lane); }
    }
}

__device__ __forceinline__ void mod_gemv(const Args& a, const Frame& F0) {
    const Frame F = phase_frame(F0);
    LAS float* sl = (LAS float*)F.lds;
    LAS float* red = (LAS float*)(F.lds + 32768);
    float* MOD = (float*)(a.ws + CTL_MOD);
    __syncthreads();
    for (int i = F.tid; i < 8 * 1024; i += NTHREADS) sl[i] = siluf_(a.in[I_C][i]);
    __syncthreads();
    const int col = F.tid & 63, kg = F.tid >> 6;
    for (int u = F.bid; u < 192; u += F.G) {
        const int l = u / 96, n = (u % 96) * 64 + col;
        float acc[8];
#pragma unroll
        for (int b = 0; b < 8; ++b) acc[b] = 0.f;
        const float* W = a.in[I_WADA] + ((size_t)l * 1024 + kg * 128) * 6144 + n;
#pragma unroll 16
        for (int kk = 0; kk < 128; ++kk) { const float w = __builtin_nontemporal_load(W + (size_t)kk * 6144);
#pragma unroll
            for (int b = 0; b < 8; ++b) acc[b] += sl[b * 1024 + kg * 128 + kk] * w; }
#pragma unroll
        for (int b = 0; b < 8; ++b) red[(kg * 8 + b) * 64 + col] = acc[b];
        __syncthreads();
        { const int b = F.tid >> 6; float s = 0.f;
#pragma unroll
          for (int g = 0; g < 8; ++g) s += red[(g * 8 + b) * 64 + col];
          MOD[(size_t)(l * 8 + b) * 6144 + n] = s; }
        __syncthreads();
    }
}

__device__ __forceinline__ void rope_table(const Args& a, const Frame& F0) {
    const Frame F = phase_frame(F0);
    f32x2* R = (f32x2*)(a.ws + WS_ROPE);
    for (int i = F.bid * NTHREADS + F.tid; i < S * 16; i += F.G * NTHREADS) {
        const int s = i >> 4, f = i & 15;
        const float inv = 1.0f / powf(10000.0f, (float)(2 * f) / 32.0f);
        const float ang = (float)s * inv;
        R[i] = (f32x2){(float)cos((double)ang), (float)sin((double)ang)};
    }
}


namespace pg8 {
constexpr int BM = 256, BK = 64, HALF = 128, HTB = HALF * BK * 2, NXCD = 8, WGM = 8;
__host__ __device__ __forceinline__ int lds_byte(int r, int c) { const int st = (r >> 4) * 2 + (c >> 5), rr = r & 15, cc = c & 31, ob = rr * 64 + cc * 2; return st * 1024 + (ob ^ (((ob >> 9) & 1) << 5)); }
__host__ __device__ __forceinline__ int perm32(int rho) { const int n = rho >> 4, i = rho & 15; return 8 * (i >> 2) + 4 * n + (i & 3); }
__host__ __device__ __forceinline__ void stage_rc(int b, int& R, int& C) { const int st = b / 1024, sb = b % 1024, swz = sb ^ (((sb >> 9) & 1) << 5); R = (st >> 1) * 16 + swz / 64; C = (st & 1) * 32 + (swz % 64) / 2; }

struct Unit { int pm, pn; long aoff, boff; int x0, x1; };
struct Gemm { const bf16_t* A; const bf16_t* Bt; int lda; int K; const int* rows; };

struct StaticOrder {
    int nM, nN, nwg, G, c; int lda, K; int kpn = 1 << 30, koff = 0;
    __device__ __forceinline__ void a_ready(const Unit&, int, int) const {}
    __device__ void init(int M, int N, int lda_, int K_, int G_, int c_) { nM = M / BM; nN = N / BM; nwg = nM * nN; G = G_; c = c_; lda = lda_; K = K_; }
    __device__ bool next(int i, Unit& u) const {
        const long L = (long)i * G + c; if (L >= nwg) return false;
        int wgid = (int)L; { const int q = nwg / NXCD, r = nwg % NXCD, xcd = wgid % NXCD, off = wgid / NXCD; wgid = (xcd < r ? xcd * (q + 1) : r * (q + 1) + (xcd - r) * q) + off; }
        const int nig = WGM * nN, gid = wgid / nig, fm = gid * WGM, gsz = (nM - fm) < WGM ? (nM - fm) : WGM;
        u.pm = fm + ((wgid % nig) % gsz); u.pn = (wgid % nig) / gsz;
        u.aoff = (long)u.pm * BM * lda + (u.pn >= kpn ? koff : 0); u.boff = (long)u.pn * BM * K; u.x0 = 0; u.x1 = 0; return true;
    }
};

template <class Epi, class Sched, bool GATHER>
__device__ __forceinline__ void gemm_phase(LAS unsigned char* lds, int wave_idx, const Gemm g, const Sched& S, const Epi& E) {
    int lane = lane_id(); LAUNDER(lane);
    int wid = wave_idx; LAUNDER_S(wid); const int tid = wid * 64 + lane;
    const int wr = wid >> 2, wc = wid & 3, fr = lane & 15, fq = lane >> 4;
    int K = g.K; LAUNDER_S(K); const int nt = K / BK;
    unsigned voffB[2];
#pragma unroll
    for (int i = 0; i < 2; ++i) { int R_, C_; stage_rc(tid * 16 + i * 8192, R_, C_); if (Epi::PERM) R_ = (R_ & ~31) + perm32(R_ & 31); voffB[i] = (unsigned)(R_ * K + C_) * 2u; }
    unsigned vA[2][2];
    const size_t kstep = (size_t)(BK * 2);
    const size_t hstepB = (size_t)HALF * K * 2;
    const unsigned ldsw = (unsigned)wid * 1024u;
    const int aoff = lds_byte(wr * 64 + fr, fq * 8), boff = lds_byte(wc * 32 + fr, fq * 8);
#define PG8_SA(b, h) (((b) * 2 + (h)) * HTB)
#define PG8_SB(b, h) ((4 + (b) * 2 + (h)) * HTB)
#define PG8_STAGE_B(bufoff, gbase) do { _Pragma("unroll") for (int _i = 0; _i < 2; ++_i) \
        __builtin_amdgcn_global_load_lds((const unsigned*)((const char*)(gbase) + voffB[_i]), (LAS unsigned*)(lds + (bufoff) + ldsw + _i * 8192), 16, 0, 0); } while (0)
#define PG8_STAGE_A(bufoff, gbase, vo, h) do { _Pragma("unroll") for (int _i = 0; _i < 2; ++_i) \
        __builtin_amdgcn_global_load_lds((const unsigned*)((const char*)(gbase) + (vo)[h][_i]), (LAS unsigned*)(lds + (bufoff) + ldsw + _i * 8192), 16, 0, 0); } while (0)
#define PG8_LDA(dst, b, h) do { _Pragma("unroll") for (int m = 0; m < 4; ++m) _Pragma("unroll") for (int k = 0; k < 2; ++k) dst[m][k] = *(const LAS bf16x8*)(lds + PG8_SA(b, h) + aoff + m * 2048 + k * 1024); } while (0)
#define PG8_LDB(dst, b, h) do { _Pragma("unroll") for (int n = 0; n < 2; ++n) _Pragma("unroll") for (int k = 0; k < 2; ++k) dst[n][k] = *(const LAS bf16x8*)(lds + PG8_SB(b, h) + boff + n * 2048 + k * 1024); } while (0)
#define PG8_MMA(ai, bj, At, Bt) do { __builtin_amdgcn_s_setprio(1); _Pragma("unroll") for (int m = 0; m < 4; ++m) _Pragma("unroll") for (int n = 0; n < 2; ++n) _Pragma("unroll") for (int k = 0; k < 2; ++k) \
        acc[ai][bj][m][n] = __builtin_amdgcn_mfma_f32_16x16x32_bf16(Bt[n][k], At[m][k], acc[ai][bj][m][n], 0, 0, 0); __builtin_amdgcn_s_setprio(0); } while (0)
#define PG8_WAIT_V(n) asm volatile("s_waitcnt vmcnt(" #n ")" ::: "memory")
#define PG8_WAIT_L(n) asm volatile("s_waitcnt lgkmcnt(" #n ")" ::: "memory")
#define PG8_BAR __builtin_amdgcn_s_barrier()
#define PG8_SCHED __builtin_amdgcn_sched_barrier(0)
#define PG8_AOFFS(dst, u) do { _Pragma("unroll") for (int _h = 0; _h < 2; ++_h) _Pragma("unroll") for (int _i = 0; _i < 2; ++_i) { int _R, _C; stage_rc(tid * 16 + _i * 8192, _R, _C); \
        if (GATHER) { const int _ri = _h * HALF + _R; const int _row = (_ri < (u).x1) ? (g.rows[(u).x0 + _ri] >> 1) : 0; dst[_h][_i] = (unsigned)((size_t)_row * g.lda + _C) * 2u; } \
        else dst[_h][_i] = (unsigned)((_h * HALF + _R) * g.lda + _C) * 2u; } } while (0)
    Unit cur, nxt; int ui = 0;
    if (!S.next(0, cur)) return;
    f32x4 acc[2][2][4][2];
#pragma unroll
    for (int a = 0; a < 2; ++a)
#pragma unroll
        for (int b = 0; b < 2; ++b)
#pragma unroll
            for (int m = 0; m < 4; ++m)
#pragma unroll
                for (int n = 0; n < 2; ++n) acc[a][b][m][n] = (f32x4){0.f, 0.f, 0.f, 0.f};
    bf16x8 At[4][2], B0[2][2], B1[2][2];
    const char* cA = (const char*)g.A + (GATHER ? (size_t)0 : (size_t)cur.aoff * 2); const char* cB = (const char*)g.Bt + (size_t)cur.boff * 2;
    S.a_ready(cur, wid, lane);
    PG8_AOFFS(vA, cur);
    PG8_STAGE_B(PG8_SB(0, 0), cB); PG8_STAGE_B(PG8_SB(0, 1), cB + hstepB); PG8_STAGE_A(PG8_SA(0, 0), cA, vA, 0); PG8_STAGE_A(PG8_SA(0, 1), cA, vA, 1);
    if (wr == 1) PG8_BAR;
    PG8_WAIT_V(2); PG8_BAR;
    PG8_STAGE_B(PG8_SB(1, 0), cB + kstep); PG8_STAGE_A(PG8_SA(1, 0), cA + kstep, vA, 0); PG8_STAGE_B(PG8_SB(1, 1), cB + hstepB + kstep);
    PG8_WAIT_V(6); PG8_BAR;
    for (;;) {
        const bool has_next = S.next(ui + 1, nxt);
        const char* nA = has_next ? (const char*)g.A + (GATHER ? (size_t)0 : (size_t)nxt.aoff * 2) : cA; const char* nB = has_next ? (const char*)g.Bt + (size_t)nxt.boff * 2 : cB;
#pragma unroll 1
        for (int t = 0; t < nt; t += 2) {
            const bool last = (t == nt - 2);
            if (last && has_next) S.a_ready(nxt, wid, lane);
            const char* a1 = cA + (size_t)(t + 1) * kstep;
            const char* a2 = last ? nA : cA + (size_t)(t + 2) * kstep; const char* b2 = last ? nB : cB + (size_t)(t + 2) * kstep;
            const char* a3 = a2 + kstep; const char* b3 = b2 + kstep;
            PG8_LDB(B0, 0, 0); PG8_LDB(B1, 0, 1); PG8_SCHED; PG8_LDA(At, 0, 0); PG8_STAGE_A(PG8_SA(1, 1), a1, vA, 1);
            PG8_WAIT_V(8); PG8_WAIT_L(0); PG8_BAR; PG8_MMA(0, 0, At, B0); PG8_MMA(0, 1, At, B1); PG8_BAR; PG8_SCHED;
            if (GATHER) { if (last && has_next) { PG8_AOFFS(vA, nxt); } }
            PG8_LDA(At, 0, 1); PG8_STAGE_B(PG8_SB(0, 0), b2); PG8_STAGE_B(PG8_SB(0, 1), b2 + hstepB); PG8_STAGE_A(PG8_SA(0, 0), a2, vA, 0);
            PG8_WAIT_V(8); PG8_WAIT_L(0); PG8_BAR; if (!GATHER || cur.x1 > HALF) { PG8_MMA(1, 0, At, B0); PG8_MMA(1, 1, At, B1); } PG8_BAR; PG8_SCHED;
            PG8_LDB(B0, 1, 0); PG8_LDB(B1, 1, 1); PG8_SCHED; PG8_LDA(At, 1, 0); PG8_STAGE_A(PG8_SA(0, 1), a2, vA, 1);
            PG8_WAIT_V(8); PG8_WAIT_L(0); PG8_BAR; PG8_MMA(0, 0, At, B0); PG8_MMA(0, 1, At, B1); PG8_BAR; PG8_SCHED;
            PG8_LDA(At, 1, 1); PG8_STAGE_B(PG8_SB(1, 0), b3); PG8_STAGE_B(PG8_SB(1, 1), b3 + hstepB); PG8_STAGE_A(PG8_SA(1, 0), a3, vA, 0);
            PG8_WAIT_V(8); PG8_WAIT_L(0); PG8_BAR; if (!GATHER || cur.x1 > HALF) { PG8_MMA(1, 0, At, B0); PG8_MMA(1, 1, At, B1); } PG8_BAR; PG8_SCHED;
        }
        { const int el = lane_id(); E(acc, cur, wr, wc, el & 15, el >> 4); E.done(cur, el); }
        if (!has_next) break;
#pragma unroll
        for (int a = 0; a < 2; ++a)
#pragma unroll
            for (int b = 0; b < 2; ++b)
#pragma unroll
                for (int m = 0; m < 4; ++m)
#pragma unroll
                    for (int n = 0; n < 2; ++n) acc[a][b][m][n] = (f32x4){0.f, 0.f, 0.f, 0.f};
        cur = nxt; cA = nA; cB = nB; ++ui;
    }
    PG8_WAIT_V(0);
    if (wr == 0) PG8_BAR;
    PG8_BAR;
#undef PG8_SA
#undef PG8_SB
#undef PG8_STAGE_A
#undef PG8_STAGE_B
#undef PG8_LDA
#undef PG8_LDB
#undef PG8_MMA
#undef PG8_WAIT_V
#undef PG8_WAIT_L
#undef PG8_BAR
#undef PG8_SCHED
#undef PG8_AOFFS
}
}


__device__ __forceinline__ int perm_s(int s) { return (s & ~12) | (((s >> 2) & 1) << 3) | (((s >> 3) & 1) << 2); }
constexpr float QS_MLA = 0.10206207261596577f * LOG2E;
constexpr float QS_DF = 0.17677669529663687f * LOG2E;

__device__ __forceinline__ u32x4 pair_cols(u32x2 n0, u32x2 n1, int fq, int& col8) {
    const auto r0 = __builtin_amdgcn_permlane16_swap(n0.x, n1.x, false, false);
    const auto r1 = __builtin_amdgcn_permlane16_swap(n0.y, n1.y, false, false);
    col8 = (fq & 1) ? 16 + 4 * (fq - 1) : 4 * fq;
    u32x4 o; o.x = r0[0]; o.y = r1[0]; o.z = r0[1]; o.w = r1[1]; return o;
}
__device__ __forceinline__ u32x4 pair_cols32(u32x2 A, u32x2 B) {
    const auto r0 = __builtin_amdgcn_permlane32_swap(A.x, B.x, false, false);
    const auto r1 = __builtin_amdgcn_permlane32_swap(A.y, B.y, false, false);
    u32x4 o; o.x = r0[0]; o.y = r1[0]; o.z = r0[1]; o.w = r1[1]; return o;
}
__device__ __forceinline__ float rope_cf(int f) { return __builtin_amdgcn_exp2f(-(float)(2 * f) * (13.287712379549449f / 32.0f)) * 0.15915494309189535f; }
__device__ __forceinline__ f32x2 rope_cs(int s, float cf) { const float x = __builtin_amdgcn_fractf((float)s * cf); return (f32x2){__builtin_amdgcn_cosf(x), __builtin_amdgcn_sinf(x)}; }
struct EpiIn {
    static constexpr bool PERM = false;
    __device__ __forceinline__ void done(const pg8::Unit&, int) const {}
    unsigned char* ws; const float* b_i; const float* b_f; int layer;
    __device__ __forceinline__ void operator()(const f32x4 (&acc)[2][2][4][2], const pg8::Unit& u, int wr, int wc, int fr, int fq) const {
        switch (u.pn) {
            case 0: run<0>(acc, u, wr, wc, fr, fq); break;   case 1: run<1>(acc, u, wr, wc, fr, fq); break;   case 2: run<2>(acc, u, wr, wc, fr, fq); break;   case 3: run<3>(acc, u, wr, wc, fr, fq); break;
            case 4: run<4>(acc, u, wr, wc, fr, fq); break;   case 5: run<5>(acc, u, wr, wc, fr, fq); break;   case 6: run<6>(acc, u, wr, wc, fr, fq); break;   case 7: run<7>(acc, u, wr, wc, fr, fq); break;
            case 8: run<8>(acc, u, wr, wc, fr, fq); break;   case 9: run<9>(acc, u, wr, wc, fr, fq); break;   case 10: run<10>(acc, u, wr, wc, fr, fq); break; default: run<11>(acc, u, wr, wc, fr, fq); break;
        }
    }
    template <int PN>
    __device__ __forceinline__ void run(const f32x4 (&acc)[2][2][4][2], const pg8::Unit& u, int wr, int wc, int fr, int fq) const {
        constexpr int pn = PN; const int b = u.pm >> 3;
        bf16_t* Z = (bf16_t*)(ws + WS_Z);
        float cfj[4];
#pragma unroll
        for (int j = 0; j < 4; ++j) cfj[j] = rope_cf(fq * 4 + j);
        int zbase = -1;
        if (pn <= 3) zbase = pn * 256; else if (pn >= 5 && pn <= 8) zbase = (pn - 1) * 256;
#pragma unroll
        for (int ai = 0; ai < 2; ++ai)
#pragma unroll
            for (int m = 0; m < 4; ++m) {
                const int r = u.pm * 256 + ai * 128 + wr * 64 + m * 16 + fr, s = r & (S - 1);
                if (zbase >= 0) {
#pragma unroll
                    for (int bj = 0; bj < 2; ++bj) { const f32x4 v0 = acc[ai][bj][m][0], v1 = acc[ai][bj][m][1];
                        u32x2 o0, o1; o0.x = pk2(v0.x, v0.y); o0.y = pk2(v0.z, v0.w); o1.x = pk2(v1.x, v1.y); o1.y = pk2(v1.z, v1.w);
                        int c8; const u32x4 o = pair_cols(o0, o1, fq, c8);
                        *(u32x4*)(Z + (size_t)r * ZLD + zbase + bj * 128 + wc * 32 + c8) = o; }
                }
                if (pn <= 1) {
                    float sq = 0.f, skv = 0.f;
#pragma unroll
                    for (int bj = 0; bj < 2; ++bj) {
                        const int cb = pn * 256 + bj * 128 + wc * 32;
                        float t = 0.f;
#pragma unroll
                        for (int n = 0; n < 2; ++n) { const f32x4 v = acc[ai][bj][m][n]; t += (v.x * v.x + v.y * v.y) + (v.z * v.z + v.w * v.w); }
                        if (cb < 192) sq += t; else if (cb < 320) skv += t;
                    }
                    sq = xor32_sum(xor16_sum(sq)); skv = xor32_sum(xor16_sum(skv));
                    if (fq == 0) *(f32x2*)((float*)(ws + WS_RSP) + ((size_t)r * 8 + pn * 4 + wc) * 2) = (f32x2){sq, skv};
                }
                if (pn == 1 && wc == 2) {
                    const f32x4 x1 = acc[ai][0][m][0], x2 = acc[ai][0][m][1];
                    float o1[4], o2[4];
#pragma unroll
                    for (int j = 0; j < 4; ++j) { const f32x2 cs = rope_cs(s, cfj[j]); o1[j] = x1[j] * cs.x - x2[j] * cs.y; o2[j] = x1[j] * cs.y + x2[j] * cs.x; }
                    u32x2 w1; w1.x = pk2(o1[0], o1[1]); w1.y = pk2(o1[2], o1[3]); u32x2 w2; w2.x = pk2(o2[0], o2[1]); w2.y = pk2(o2[2], o2[3]);
                    bf16_t* KM = (bf16_t*)(ws + WS_KM);
#pragma unroll
                    for (int h = 0; h < 4; ++h) { bf16_t* kr = KM + ((size_t)(b * 4 + h) * S + s) * 96 + 64 + fq * 4; *(u32x2*)kr = w1; *(u32x2*)(kr + 16) = w2; }
                }
                if (pn == 1 && wc == 3 && fq < 2) {
                    const f32x4 v = acc[ai][0][m][0]; const float* bias = (fq == 0 ? b_i : b_f) + layer * 4;
                    float* G = (float*)(ws + WS_GATES) + (size_t)r * 8 + fq * 4;
                    *(f32x4*)G = (f32x4){v.x + bias[0], v.y + bias[1], v.z + bias[2], v.w + bias[3]};
                }
                if (pn == 3 || pn == 4 || pn == 11) {
                    bf16_t* XT = (bf16_t*)(ws + (pn == 3 ? WS_MKT : (pn == 4 ? WS_MVT : WS_DVT)));
                    const int sp = perm_s(s);
#pragma unroll
                    for (int bj = 0; bj < 2; ++bj)
#pragma unroll
                        for (int n = 0; n < 2; ++n) { const f32x4 v = acc[ai][bj][m][n];
                            const int col = bj * 128 + wc * 32 + n * 16 + fq * 4;
#pragma unroll
                            for (int j = 0; j < 4; ++j) { const int c = col + j; XT[((size_t)(b * 4 + (c >> 6)) * 64 + (c & 63)) * S + sp] = (bf16_t)(pk2(v[j], 0.f) & 0xffffu); } }
                }
                if (pn == 9 || pn == 10) {
                    bf16_t* XD = (bf16_t*)(ws + (pn == 9 ? WS_QD : WS_KD)); const float sc = (pn == 9) ? QS_DF : 1.0f;
#pragma unroll
                    for (int bj = 0; bj < 2; ++bj) {
                        const f32x4 x1 = acc[ai][bj][m][0], x2 = acc[ai][bj][m][1];
                        float o1[4], o2[4];
#pragma unroll
                        for (int j = 0; j < 4; ++j) { const f32x2 cs = rope_cs(s, cfj[j]); o1[j] = (x1[j] * cs.x - x2[j] * cs.y) * sc; o2[j] = (x1[j] * cs.y + x2[j] * cs.x) * sc; }
                        u32x2 w1; w1.x = pk2(o1[0], o1[1]); w1.y = pk2(o1[2], o1[3]); u32x2 w2; w2.x = pk2(o2[0], o2[1]); w2.y = pk2(o2[2], o2[3]);
                        int c8; const u32x4 o = pair_cols(w1, w2, fq, c8);
                        *(u32x4*)(XD + ((size_t)(b * 8 + bj * 4 + wc) * S + s) * 32 + c8) = o;
                    }
                }
            }
    }
};

struct EpiUp {
    static constexpr bool PERM = false;
    __device__ __forceinline__ void done(const pg8::Unit&, int) const {}
    unsigned char* ws; int layer; LAS unsigned char* lds;
    __device__ __forceinline__ void operator()(const f32x4 (&acc)[2][2][4][2], const pg8::Unit& u, int wr, int wc, int fr, int fq) const {
        const int pn = u.pn, b = u.pm >> 3;
        float cfj[4];
#pragma unroll
        for (int j = 0; j < 4; ++j) cfj[j] = rope_cf(fq * 4 + j);
        bf16_t* QM = (bf16_t*)(ws + WS_QM); bf16_t* KM = (bf16_t*)(ws + WS_KM); bf16_t* VT = (bf16_t*)(ws + WS_VTM);
        LAS f32x2* rs2 = (LAS f32x2*)(lds + LDS_MISC + 4096);
        { const int tl = (wr * 4 + wc) * 64 + fq * 16 + fr;
          if (tl < 256) { const f32x4* rp = (const f32x4*)((const float*)(ws + WS_RSP) + ((size_t)u.pm * 256 + tl) * 16); f32x2 ss = (f32x2){0.f, 0.f};
#pragma unroll
              for (int q4 = 0; q4 < 4; ++q4) { const f32x4 t4 = rp[q4]; ss.x += t4.x + t4.z; ss.y += t4.y + t4.w; }
              rs2[tl] = (f32x2){__builtin_amdgcn_rsqf(ss.x * (1.0f / 192.0f) + RMS_EPS), __builtin_amdgcn_rsqf(ss.y * (1.0f / 128.0f) + RMS_EPS)}; }
          asm volatile("s_waitcnt lgkmcnt(0)" ::: "memory"); __builtin_amdgcn_s_barrier(); asm volatile("" ::: "memory"); }
#pragma unroll
        for (int ai = 0; ai < 2; ++ai)
#pragma unroll
            for (int m = 0; m < 4; ++m) {
                const int r = u.pm * 256 + ai * 128 + wr * 64 + m * 16 + fr, s = r & (S - 1);
                const f32x2 rr = rs2[ai * 128 + wr * 64 + m * 16 + fr];
                const float rq = rr.x, rkv = rr.y;
                if (pn == 0 || pn == 2) {
                    bf16_t* X = (pn == 0) ? QM : KM; const float sc = (pn == 0) ? rq * QS_MLA : rkv;
#pragma unroll
                    for (int bj = 0; bj < 2; ++bj)
#pragma unroll
                        for (int n = 0; n < 2; ++n) { const f32x4 v = acc[ai][bj][m][n] * sc; const int col = bj * 128 + wc * 32 + n * 16 + fq * 4;
                            u32x2 o; o.x = pk2(v.x, v.y); o.y = pk2(v.z, v.w);
                            *(u32x2*)(X + ((size_t)(b * 4 + (col >> 6)) * S + s) * 96 + (col & 63)) = o; }
                } else if (pn == 1) {
                    const f32x4 x1 = acc[ai][0][m][0], x2 = acc[ai][0][m][1]; const float sc = rq * QS_MLA;
                    float o1[4], o2[4];
#pragma unroll
                    for (int j = 0; j < 4; ++j) { const f32x2 cs = rope_cs(s, cfj[j]); o1[j] = (x1[j] * cs.x - x2[j] * cs.y) * sc; o2[j] = (x1[j] * cs.y + x2[j] * cs.x) * sc; }
                    u32x2 w1; w1.x = pk2(o1[0], o1[1]); w1.y = pk2(o1[2], o1[3]); u32x2 w2; w2.x = pk2(o2[0], o2[1]); w2.y = pk2(o2[2], o2[3]);
                    bf16_t* dst = QM + ((size_t)(b * 4 + wc) * S + s) * 96 + 64 + fq * 4; *(u32x2*)dst = w1; *(u32x2*)(dst + 16) = w2;
                } else {
                    const int sp = perm_s(s);
#pragma unroll
                    for (int bj = 0; bj < 2; ++bj)
#pragma unroll
                        for (int n = 0; n < 2; ++n) { const f32x4 v = acc[ai][bj][m][n] * rkv; const int col = bj * 128 + wc * 32 + n * 16 + fq * 4;
#pragma unroll
                            for (int j = 0; j < 4; ++j) { const int c = col + j; VT[((size_t)(b * 4 + (c >> 6)) * 64 + (c & 63)) * S + sp] = (bf16_t)(pk2(v[j], 0.f) & 0xffffu); } }
                }
            }
    }
};

struct EpiOut {
    static constexpr bool PERM = true;
    __device__ __forceinline__ void done(const pg8::Unit&, int) const {}
    unsigned char* ws;
    __device__ __forceinline__ void operator()(const f32x4 (&acc)[2][2][4][2], const pg8::Unit& u, int wr, int wc, int fr, int fq) const {
        bf16_t* PRE = (bf16_t*)(ws + WS_PRE);
#pragma unroll
        for (int bj = 0; bj < 2; ++bj) {
            const int c = u.pn * 256 + bj * 128 + wc * 32 + fq * 8;
#pragma unroll
            for (int ai = 0; ai < 2; ++ai)
#pragma unroll
                for (int m = 0; m < 4; ++m) {
                    const int r = u.pm * 256 + ai * 128 + wr * 64 + m * 16 + fr;
                    const f32x4 pa = acc[ai][bj][m][0], pb = acc[ai][bj][m][1];
                    u32x4 o; o.x = pk2(pa.x, pa.y); o.y = pk2(pa.z, pa.w); o.z = pk2(pb.x, pb.y); o.w = pk2(pb.z, pb.w);
                    *(u32x4*)(PRE + (size_t)r * D + c) = o;
                }
        }
    }
};


constexpr int MOE_MAXT = 160;
constexpr int LM_NT = 16, LM_TT = 32, LM_VV = 32 + MOE_MAXT, LM_EB = 32 + 2 * MOE_MAXT, LM_EN = LM_EB + 16;

__device__ __forceinline__ float top2sum4(float a, float b, float c, float d) {
    return fmaxf(fmaxf(fmaxf(a + b, a + c), fmaxf(a + d, b + c)), fmaxf(b + d, c + d));
}
__device__ __forceinline__ void route_select(const float (&lg)[16], const float* br, int& e0, int& e1, float& w0, float& w1) {
    float sc[16], sel[16];
#pragma unroll
    for (int e = 0; e < 16; ++e) { sc[e] = __builtin_amdgcn_rcpf(1.0f + __expf(-lg[e])); sel[e] = sc[e] + br[e]; }
    float gs[4];
#pragma unroll
    for (int g = 0; g < 4; ++g) gs[g] = top2sum4(sel[4 * g], sel[4 * g + 1], sel[4 * g + 2], sel[4 * g + 3]);
    int gb = 0; float gv = gs[0];
#pragma unroll
    for (int g = 1; g < 4; ++g) if (gs[g] > gv) { gv = gs[g]; gb = g; }
    float s4[4], c4[4];
#pragma unroll
    for (int i = 0; i < 4; ++i) { s4[i] = gb == 0 ? sel[i] : gb == 1 ? sel[4 + i] : gb == 2 ? sel[8 + i] : sel[12 + i]; c4[i] = gb == 0 ? sc[i] : gb == 1 ? sc[4 + i] : gb == 2 ? sc[8 + i] : sc[12 + i]; }
    int i0 = 0; float v0 = s4[0], cw0 = c4[0];
#pragma unroll
    for (int i = 1; i < 4; ++i) if (s4[i] > v0) { v0 = s4[i]; i0 = i; cw0 = c4[i]; }
    int i1 = -1; float v1 = -INFINITY, cw1 = 0.f;
#pragma unroll
    for (int i = 0; i < 4; ++i) if (i != i0 && s4[i] > v1) { v1 = s4[i]; i1 = i; cw1 = c4[i]; }
    e0 = gb * 4 + i0; e1 = gb * 4 + i1; const float inv = __builtin_amdgcn_rcpf(cw0 + cw1); w0 = cw0 * inv; w1 = cw1 * inv;
}

template <class NF>
__device__ __forceinline__ int xq_claim(unsigned* qbase, int xcc, bool& own_live, const NF& nof) {
    const int lane = lane_id();
    if (own_live) {
        unsigned j = 0; if (lane == 0) j = __hip_atomic_fetch_add(qbase + 64 * xcc, 1u, __ATOMIC_RELAXED, __HIP_MEMORY_SCOPE_AGENT);
        j = (unsigned)__builtin_amdgcn_readfirstlane((int)j);
        if (j < nof(xcc)) return (xcc << 16) | (int)j;
        own_live = false;
    }
    for (int it = 0; it < 8; ++it) {
        const int q = (xcc + (lane & 7)) & 7;
        unsigned c = 0xffffffffu; if (lane < 8) c = __hip_atomic_load(qbase + 64 * q, __ATOMIC_RELAXED, __HIP_MEMORY_SCOPE_AGENT);
        const unsigned long long m = __ballot(lane < 8 && c < nof(q));
        if (m == 0ull) return -1;
        const int qs = (xcc + (__ffsll((long long)m) - 1)) & 7;
        unsigned j = 0; if (lane == 0) j = __hip_atomic_fetch_add(qbase + 64 * qs, 1u, __ATOMIC_RELAXED, __HIP_MEMORY_SCOPE_AGENT);
        j = (unsigned)__builtin_amdgcn_readfirstlane((int)j);
        if (j < nof(qs)) return (qs << 16) | (int)j;
    }
    return -1;
}
__device__ __forceinline__ void moe_tile_table(const Frame& F0, int layer) {
    const Frame F = phase_frame(F0);
    volatile LAS unsigned* MISC = (volatile LAS unsigned*)(F.lds + LDS_MISC);
    __syncthreads();
    if (F.wave == 0) {
        const int e = F.lane; int cnt = 0;
        if (e < NEXP) cnt = (int)__hip_atomic_load(F.ctl + CW_CNT + 64 * (16 * layer + e), __ATOMIC_RELAXED, __HIP_MEMORY_SCOPE_AGENT);
        const int ntl = (cnt + 255) >> 8; int incl = ntl;
#define SCAN_STEP(CTRL) incl += __builtin_amdgcn_update_dpp(0, incl, CTRL, 0xf, 0xf, false)
        SCAN_STEP(0x111); SCAN_STEP(0x112); SCAN_STEP(0x114); SCAN_STEP(0x118);
#undef SCAN_STEP
        const int base = incl - ntl;
        for (int t = 0; t < ntl; ++t) { const int gt = base + t; if (gt < MOE_MAXT) { MISC[LM_TT + gt] = ((unsigned)e << 16) | (unsigned)t; const int v = cnt - t * 256; MISC[LM_VV + gt] = (unsigned)(v < 256 ? v : 256); } }
        if (e < NEXP) { MISC[LM_EB + e] = (unsigned)base; MISC[LM_EN + e] = (unsigned)ntl; }
        if (e == NEXP - 1) MISC[LM_NT] = (unsigned)(incl < MOE_MAXT ? incl : MOE_MAXT);
    }
    __syncthreads();
}
struct MoeOrder {
    const volatile LAS unsigned* MISC; int npn, which;
    unsigned* queue; int wave;
    unsigned* ready;
    int xcc; mutable bool own_live;
    __device__ __forceinline__ void a_ready(const pg8::Unit& u, int wid, int lane) const {
        if (which != 2) return;
        if (wid == 0) { unsigned spins = 0;
            while ((unsigned)__builtin_amdgcn_readfirstlane((int)__hip_atomic_load(ready + 64 * u.pm, __ATOMIC_RELAXED, __HIP_MEMORY_SCOPE_AGENT)) < 16u) { __builtin_amdgcn_s_sleep(2); if (++spins > (1u << 22)) break; }
            __builtin_amdgcn_fence(__ATOMIC_ACQUIRE, "agent");
            asm volatile("s_waitcnt vmcnt(0)" ::: "memory"); }
        asm volatile("" ::: "memory"); __builtin_amdgcn_s_barrier(); asm volatile("" ::: "memory");
    }
    __device__ bool next(int i, pg8::Unit& u) const {
        volatile LAS unsigned* slot = const_cast<volatile LAS unsigned*>(MISC) + 24 + (i & 1);
        const int sh = (npn == 4) ? 2 : 1;
        if (wave == 0) {
            const volatile LAS unsigned* M = MISC;
            const int r = xq_claim(queue, xcc, own_live, [M, sh](int q) { return (unsigned)((M[LM_EN + q] + M[LM_EN + q + 8]) << sh); });
            if (lane_id() == 0) *slot = (unsigned)r;
            asm volatile("s_waitcnt vmcnt(0) lgkmcnt(0)" ::: "memory"); }
        asm volatile("" ::: "memory"); __builtin_amdgcn_s_barrier(); asm volatile("" ::: "memory");
        const int L = __builtin_amdgcn_readfirstlane((int)*slot); if (L < 0) return false;
        const int q = L >> 16, j = L & 0xffff, jt = j >> sh, pn = j & (npn - 1);
        const int n1 = __builtin_amdgcn_readfirstlane((int)MISC[LM_EN + q]), n2 = __builtin_amdgcn_readfirstlane((int)MISC[LM_EN + q + 8]);
        const int e1b = __builtin_amdgcn_readfirstlane((int)MISC[LM_EB + q]), e2b = __builtin_amdgcn_readfirstlane((int)MISC[LM_EB + q + 8]);
        const int p1 = (n1 > 0 && __builtin_amdgcn_readfirstlane((int)MISC[LM_VV + e1b + (n1 > 0 ? n1 - 1 : 0)]) < 256) ? 1 : 0;
        const int p2 = (n2 > 0 && __builtin_amdgcn_readfirstlane((int)MISC[LM_VV + e2b + (n2 > 0 ? n2 - 1 : 0)]) < 256) ? 1 : 0;
        const int f1 = n1 - p1, f2 = n2 - p2;
        int gt;
        if (jt < f1) gt = e1b + jt; else if (jt < f1 + f2) gt = e2b + (jt - f1);
        else if (jt == f1 + f2 && p1) gt = e1b + n1 - 1; else gt = e2b + n2 - 1;
        const unsigned tt = (unsigned)__builtin_amdgcn_readfirstlane((int)MISC[LM_TT + gt]); const int e = (int)(tt >> 16), tile = (int)(tt & 0xffffu);
        u.pm = gt; u.pn = pn; u.x0 = e * T + tile * 256; u.x1 = __builtin_amdgcn_readfirstlane((int)MISC[LM_VV + gt]);
        if (which == 1) { u.aoff = 0; u.boff = ((long)e * 512 + pn * 256) * 1024; }
        else { u.aoff = (long)gt * 256 * 256; u.boff = ((long)e * 1024 + pn * 256) * 256; }
        return true;
    }
};
struct EpiMoe1 {
    static constexpr bool PERM = true;
    unsigned char* ws; unsigned* ready; LAS unsigned char* lds;
    __device__ __forceinline__ void done(const pg8::Unit& u, int lane) const {
        asm volatile("s_waitcnt vmcnt(0)" ::: "memory");
        if (lane == 0) __hip_atomic_fetch_add(ready + 64 * u.pm, 1u, __ATOMIC_RELAXED, __HIP_MEMORY_SCOPE_AGENT);
    }
    __device__ __forceinline__ void operator()(const f32x4 (&acc)[2][2][4][2], const pg8::Unit& u, int wr, int wc, int fr, int fq) const {
        const int* LIST = (const int*)(ws + WS_LIST); const float* ROUTE = (const float*)(ws + WS_ROUTE);
        LAS float* gl = (LAS float*)(lds + LDS_MISC + 4096);
        { const int tl = (wr * 4 + wc) * 64 + fq * 16 + fr;
          if (tl < 256) { float g = 0.f; if (tl < u.x1) { const int code = LIST[u.x0 + tl]; g = ROUTE[code]; } gl[tl] = g; }
          asm volatile("s_waitcnt lgkmcnt(0)" ::: "memory"); __builtin_amdgcn_s_barrier(); asm volatile("" ::: "memory"); }
        const __amdgpu_buffer_rsrc_t hres = __builtin_amdgcn_make_buffer_rsrc(ws + WS_H, 0, MOE_MAXT * 256 * 256 * 2, 0x00020000);
#pragma unroll
        for (int ai = 0; ai < 2; ++ai)
#pragma unroll
            for (int m = 0; m < 4; ++m) {
                const int ri = ai * 128 + wr * 64 + m * 16 + fr;
                const float gate = gl[ri];
                u32x4 o;
                { const f32x4 a1 = acc[ai][0][m][0], a3 = acc[ai][1][m][0]; f32x4 h;
#pragma unroll
                  for (int j = 0; j < 4; ++j) h[j] = a1[j] * __builtin_amdgcn_rcpf(1.0f + __expf(-a1[j])) * a3[j] * gate;
                  o.x = pk2(h.x, h.y); o.y = pk2(h.z, h.w); }
                { const f32x4 a1 = acc[ai][0][m][1], a3 = acc[ai][1][m][1]; f32x4 h;
#pragma unroll
                  for (int j = 0; j < 4; ++j) h[j] = a1[j] * __builtin_amdgcn_rcpf(1.0f + __expf(-a1[j])) * a3[j] * gate;
                  o.z = pk2(h.x, h.y); o.w = pk2(h.z, h.w); }
                __builtin_amdgcn_raw_buffer_store_b128(o, hres, (int)((((size_t)u.pm * 256 + ri) * 256 + u.pn * 128 + wc * 32 + fq * 8) * 2), 0, 16);
            }
    }
};
struct EpiMoe2 {
    static constexpr bool PERM = true;
    __device__ __forceinline__ void done(const pg8::Unit&, int) const {}
    unsigned char* ws; LAS unsigned char* lds;
    __device__ __forceinline__ void operator()(const f32x4 (&acc)[2][2][4][2], const pg8::Unit& u, int wr, int wc, int fr, int fq) const {
        bf16_t* YB = (bf16_t*)(ws + WS_YB); const int* LIST = (const int*)(ws + WS_LIST);
        LAS int* cl = (LAS int*)(lds + LDS_MISC + 4096);
        { const int tl = (wr * 4 + wc) * 64 + fq * 16 + fr;
          if (tl < 256) cl[tl] = (tl < u.x1) ? LIST[u.x0 + tl] : -1;
          asm volatile("s_waitcnt lgkmcnt(0)" ::: "memory"); __builtin_amdgcn_s_barrier(); asm volatile("" ::: "memory"); }
#pragma unroll
        for (int ai = 0; ai < 2; ++ai)
#pragma unroll
            for (int m = 0; m < 4; ++m) {
                const int ri = ai * 128 + wr * 64 + m * 16 + fr;
                const int code = cl[ri];
                if (code >= 0) {
#pragma unroll
                    for (int bj = 0; bj < 2; ++bj) { const f32x4 v0 = acc[ai][bj][m][0], v1 = acc[ai][bj][m][1];
                        u32x4 o; o.x = pk2(v0.x, v0.y); o.y = pk2(v0.z, v0.w); o.z = pk2(v1.x, v1.y); o.w = pk2(v1.z, v1.w);
                        *(u32x4*)(YB + (size_t)code * D + u.pn * 256 + bj * 128 + wc * 32 + fq * 8) = o; } }
            }
    }
};


__device__ __forceinline__ int queue_next(const Frame& F, int qi) {
    volatile LAS int* slot = (volatile LAS int*)(F.lds + LDS_MISC + 64);
    __syncthreads();
    if (F.tid == 0) *slot = (int)__hip_atomic_fetch_add(F.ctl + CW_Q + 64 * qi, 1u, __ATOMIC_RELAXED, __HIP_MEMORY_SCOPE_AGENT);
    __syncthreads();
    return __builtin_amdgcn_readfirstlane(*slot);
}

__device__ __forceinline__ int queue_next_xcd(const Frame& F, int qi, int xcc, int nitems, bool& own_live) {
    volatile LAS int* slot = (volatile LAS int*)(F.lds + LDS_MISC + 64);
    __syncthreads();
    if (F.wave == 0) {
        const int r = xq_claim(F.ctl + CW_Q + 64 * (qi * 8), xcc, own_live, [nitems](int) { return (unsigned)nitems; });
        if (lane_id() == 0) *slot = r;
    }
    __syncthreads();
    return __builtin_amdgcn_readfirstlane(*slot);
}

__device__ __forceinline__ int crow(int r, int h) { return (r & 3) + 8 * (r >> 2) + 4 * h; }
template <int DK>
struct AttnLds { static constexpr int KSTR = DK * 2 + 16, VSTR = 272, KB = 128 * KSTR, VB = 64 * VSTR, K0 = 0, K1 = KB, V0 = 2 * KB, TOTAL = 2 * KB + 3 * VB; };

template <int DK>
__device__ __forceinline__ void attn_map(const Frame& F, const bf16_t* Qp, const bf16_t* Kp, const bf16_t* VTp, int qb, f32x16 (&o)[2], float& lsum) {
    typedef AttnLds<DK> L;
    constexpr int KS = DK / 16, KPR = DK * 2 / 16;
    constexpr int NKP = 128 * KPR, NKI = (NKP + 511) / 512;
    const int lane = F.lane, r32 = lane & 31, h = lane >> 5, wave = F.wave, tid = F.tid;
    LAS unsigned char* lds = F.lds;
    const int q = qb * 256 + wave * 32 + r32;
    bf16x8 qf[KS];
#pragma unroll
    for (int s = 0; s < KS; ++s) qf[s] = *(const bf16x8*)(Qp + (size_t)q * DK + s * 16 + h * 8);
    const int NT = 2 * qb + 2, tmax = 2 * qb + (wave >> 2);
    const bool defer = wave >= 4;
    float m_run = -INFINITY, l_run = 0.f;
#pragma unroll
    for (int i = 0; i < 16; ++i) { o[0][i] = 0.f; o[1][i] = 0.f; }
    u32x4 kreg[NKI], vreg[2];
#pragma unroll
    for (int i = 0; i < NKI; ++i) kreg[i] = (u32x4){0u, 0u, 0u, 0u};
    u32x4 pws[8];
#pragma unroll
    for (int i = 0; i < 8; ++i) pws[i] = (u32x4){0u, 0u, 0u, 0u};
    int pend_slot = -1;
#define ATT_LOAD(t) do { _Pragma("unroll") for (int i_ = 0; i_ < NKI; ++i_) { const int p_ = tid + 512 * i_; if (NKP % 512 == 0 || p_ < NKP) kreg[i_] = *(const u32x4*)(Kp + ((size_t)(t) * 128 + p_ / KPR) * DK + (p_ % KPR) * 8); } \
        _Pragma("unroll") for (int i_ = 0; i_ < 2; ++i_) { const int p_ = tid + 512 * i_; vreg[i_] = *(const u32x4*)(VTp + (size_t)(p_ >> 4) * S + (t) * 128 + (p_ & 15) * 8); } } while (0)
#define ATT_STORE(kbuf, vslot) do { _Pragma("unroll") for (int i_ = 0; i_ < NKI; ++i_) { const int p_ = tid + 512 * i_; if (NKP % 512 == 0 || p_ < NKP) *(LAS u32x4*)(lds + ((kbuf) ? L::K1 : L::K0) + (p_ / KPR) * L::KSTR + (p_ % KPR) * 16) = kreg[i_]; } \
        _Pragma("unroll") for (int i_ = 0; i_ < 2; ++i_) { const int p_ = tid + 512 * i_; *(LAS u32x4*)(lds + L::V0 + (vslot) + (p_ >> 4) * L::VSTR + (p_ & 15) * 16) = vreg[i_]; } } while (0)
#define ATT_PV(vslot) do { const LAS unsigned char* vb_ = lds + L::V0 + (vslot) + r32 * L::VSTR + h * 16; bf16x8 vfa_[4], vfb_[4]; \
        _Pragma("unroll") for (int f_ = 0; f_ < 4; ++f_) vfa_[f_] = *(const LAS bf16x8*)(vb_ + (f_ & 1) * 32 * L::VSTR + ((f_ >> 1) * 16) * 2); \
        _Pragma("unroll") for (int b4_ = 0; b4_ < 4; ++b4_) { \
            if (b4_ < 3) { _Pragma("unroll") for (int f_ = 0; f_ < 4; ++f_) { const bf16x8 nf_ = *(const LAS bf16x8*)(vb_ + (f_ & 1) * 32 * L::VSTR + ((b4_ + 1) * 32 + (f_ >> 1) * 16) * 2); if (b4_ & 1) vfa_[f_] = nf_; else vfb_[f_] = nf_; } } \
            __builtin_amdgcn_sched_barrier(0); \
            _Pragma("unroll") for (int s2_ = 0; s2_ < 2; ++s2_) { const bf16x8 bfrag_ = __builtin_bit_cast(bf16x8, pws[b4_ * 2 + s2_]); \
                _Pragma("unroll") for (int db_ = 0; db_ < 2; ++db_) o[db_] = __builtin_amdgcn_mfma_f32_32x32x16_bf16((b4_ & 1) ? vfb_[s2_ * 2 + db_] : vfa_[s2_ * 2 + db_], bfrag_, o[db_], 0, 0, 0); } } } while (0)
    __syncthreads();
    ATT_LOAD(0); ATT_STORE(0, 0);
    __syncthreads();
    int vs_cur = 0;
    for (int t = 0; t < NT; ++t) {
        const int buf = t & 1;
        const int vs_next = (vs_cur == 2 * L::VB) ? 0 : vs_cur + L::VB;
        if (t + 1 < NT) ATT_LOAD(t + 1);
        if (pend_slot >= 0) { ATT_PV(pend_slot); pend_slot = -1; }
        if (t <= tmax) {
            const LAS unsigned char* kb = lds + (buf ? L::K1 : L::K0) + r32 * L::KSTR + h * 16;
            f32x16 p[4];
            bf16x8 kfa[KS], kfb[KS];
#pragma unroll
            for (int s = 0; s < KS; ++s) kfa[s] = *(const LAS bf16x8*)(kb + s * 32);
#pragma unroll
            for (int b4 = 0; b4 < 4; ++b4) {
#pragma unroll
                for (int i = 0; i < 16; ++i) p[b4][i] = 0.f;
                if (b4 < 3) {
#pragma unroll
                    for (int s = 0; s < KS; ++s) { const bf16x8 nf = *(const LAS bf16x8*)(kb + (b4 + 1) * 32 * L::KSTR + s * 32); if (b4 & 1) kfa[s] = nf; else kfb[s] = nf; } }
                __builtin_amdgcn_sched_barrier(0);
#pragma unroll
                for (int s = 0; s < KS; ++s) p[b4] = __builtin_amdgcn_mfma_f32_32x32x16_bf16((b4 & 1) ? kfb[s] : kfa[s], qf[s], p[b4], 0, 0, 0);
            }
            if (t == tmax) {
                const int kbase = t * 128 + 4 * h;
#pragma unroll
                for (int b4 = 0; b4 < 4; ++b4)
#pragma unroll
                    for (int r = 0; r < 16; ++r) { const int kv = kbase + b4 * 32 + (r & 3) + 8 * (r >> 2); if (kv > q) p[b4][r] = -INFINITY; }
            }
            float mx = p[0][0];
#pragma unroll
            for (int b4 = 0; b4 < 4; ++b4)
#pragma unroll
                for (int r = 0; r < 16; ++r) mx = fmaxf(mx, p[b4][r]);
            mx = xor32_max(mx);
            const bool grew = __any(mx > m_run + 8.0f);
            const float m_new = grew ? fmaxf(m_run, mx) : m_run;
            const float alpha = grew ? __builtin_amdgcn_exp2f(m_run - m_new) : 1.0f;
            m_run = m_new;
            float rs = 0.f;
#pragma unroll
            for (int b4 = 0; b4 < 4; ++b4)
#pragma unroll
                for (int r = 0; r < 16; ++r) { p[b4][r] = __builtin_amdgcn_exp2f(p[b4][r] - m_new); rs += p[b4][r]; }
            if (grew) { l_run *= alpha;
#pragma unroll
                for (int i = 0; i < 16; ++i) { o[0][i] *= alpha; o[1][i] *= alpha; } }
            l_run += rs;
#pragma unroll
            for (int b4 = 0; b4 < 4; ++b4)
#pragma unroll
                for (int s2 = 0; s2 < 2; ++s2) { u32x4 pw; pw.x = pk2(p[b4][8 * s2], p[b4][8 * s2 + 1]); pw.y = pk2(p[b4][8 * s2 + 2], p[b4][8 * s2 + 3]); pw.z = pk2(p[b4][8 * s2 + 4], p[b4][8 * s2 + 5]); pw.w = pk2(p[b4][8 * s2 + 6], p[b4][8 * s2 + 7]);
                    pws[b4 * 2 + s2] = pw; }
            if (defer) pend_slot = vs_cur; else ATT_PV(vs_cur);
        }
        if (t + 1 < NT) ATT_STORE(buf ^ 1, vs_next);
        __syncthreads();
        vs_cur = vs_next;
    }
    if (pend_slot >= 0) ATT_PV(pend_slot);
#undef ATT_LOAD
#undef ATT_STORE
#undef ATT_PV
    lsum = xor32_sum(l_run);
}

__device__ __forceinline__ void mla_unit(const Args& a, const Frame& F0, int bh, int qb) {
    const Frame F = phase_frame(F0);
    const bf16_t* Qp = (const bf16_t*)(a.ws + WS_QM) + (size_t)bh * S * 96;
    const bf16_t* Kp = (const bf16_t*)(a.ws + WS_KM) + (size_t)bh * S * 96;
    const bf16_t* VTp = (const bf16_t*)(a.ws + WS_VTM) + (size_t)bh * 64 * S;
    f32x16 o[2]; float l;
    attn_map<96>(F, Qp, Kp, VTp, qb, o, l);
    const float inv = 1.0f / l;
    const int r32 = F.lane & 31, h = F.lane >> 5, b = bh >> 2, head = bh & 3;
    bf16_t* orow = (bf16_t*)(a.ws + WS_MIX) + ((size_t)b * S + qb * 256 + F.wave * 32 + r32) * D + head * 64;
#pragma unroll
    for (int db = 0; db < 2; ++db)
#pragma unroll
        for (int k = 0; k < 2; ++k) { u32x2 A, B; const int g = 2 * k;
            A.x = pk2(o[db][4 * g] * inv, o[db][4 * g + 1] * inv); A.y = pk2(o[db][4 * g + 2] * inv, o[db][4 * g + 3] * inv);
            B.x = pk2(o[db][4 * g + 4] * inv, o[db][4 * g + 5] * inv); B.y = pk2(o[db][4 * g + 6] * inv, o[db][4 * g + 7] * inv);
            *(u32x4*)(orow + db * 32 + 8 * (g + h)) = pair_cols32(A, B); }
}
__device__ __forceinline__ void diff_unit(const Args& a, const Frame& F0, int layer, int bh, int qb) {
    const Frame F = phase_frame(F0);
    const int b = bh >> 2, head = bh & 3;
    const bf16_t* VTp = (const bf16_t*)(a.ws + WS_DVT) + (size_t)bh * 64 * S;
    f32x16 oa[2], ob[2]; float la, lb;
    { const size_t off = ((size_t)(b * 8 + head * 2) * S) * 32; attn_map<32>(F, (const bf16_t*)(a.ws + WS_QD) + off, (const bf16_t*)(a.ws + WS_KD) + off, VTp, qb, oa, la); }
    { const size_t off = ((size_t)(b * 8 + head * 2 + 1) * S) * 32; attn_map<32>(F, (const bf16_t*)(a.ws + WS_QD) + off, (const bf16_t*)(a.ws + WS_KD) + off, VTp, qb, ob, lb); }
    float d1 = 0.f, d2 = 0.f;
    if (F.lane < 32) { d1 = a.in[I_LQ1][layer * 32 + F.lane] * a.in[I_LK1][layer * 32 + F.lane]; d2 = a.in[I_LQ2][layer * 32 + F.lane] * a.in[I_LK2][layer * 32 + F.lane]; }
    d1 = wave_sum(d1); d2 = wave_sum(d2);
    const float lam_init = 0.8f - 0.6f * expf(-0.3f * (float)layer);
    const float lam = expf(d1) - expf(d2) + lam_init;
    const float ia = 1.0f / la, ib = lam / lb;
    float ss = 0.f;
#pragma unroll
    for (int db = 0; db < 2; ++db)
#pragma unroll
        for (int i = 0; i < 16; ++i) { oa[db][i] = oa[db][i] * ia - ob[db][i] * ib; ss += oa[db][i] * oa[db][i]; }
    ss = xor32_sum(ss);
    const float rn = (1.0f / sqrtf(ss * (1.0f / 64.0f) + RMS_EPS)) * (1.0f - lam_init);
    const int r32 = F.lane & 31, h = F.lane >> 5;
    bf16_t* orow = (bf16_t*)(a.ws + WS_MIX) + ((size_t)b * S + qb * 256 + F.wave * 32 + r32) * D + 768 + head * 64;
    const float* gs = a.in[I_DFG] + layer * 64;
#pragma unroll
    for (int db = 0; db < 2; ++db)
#pragma unroll
        for (int k = 0; k < 2; ++k) { const int g = 2 * k, dva = db * 32 + 8 * g + 4 * h, dvb = dva + 8;
            const f32x4 ga = *(const f32x4*)(gs + dva), gb = *(const f32x4*)(gs + dvb);
            u32x2 A, B;
            A.x = pk2(oa[db][4 * g] * rn * ga.x, oa[db][4 * g + 1] * rn * ga.y); A.y = pk2(oa[db][4 * g + 2] * rn * ga.z, oa[db][4 * g + 3] * rn * ga.w);
            B.x = pk2(oa[db][4 * g + 4] * rn * gb.x, oa[db][4 * g + 5] * rn * gb.y); B.y = pk2(oa[db][4 * g + 6] * rn * gb.z, oa[db][4 * g + 7] * rn * gb.w);
            *(u32x4*)(orow + db * 32 + 8 * (g + h)) = pair_cols32(A, B); }
}

__device__ __forceinline__ void conv_item(const Args& a, const Frame& F0, int layer, int item) {
    const Frame F = phase_frame(F0);
    const bf16_t* Z = (const bf16_t*)(a.ws + WS_Z); bf16_t* MIXp = (bf16_t*)(a.ws + WS_MIX); const float* W = a.in[I_SCW] + (size_t)layer * 3 * 256;
    for (int i = item * 4096 + F.tid; i < (item + 1) * 4096; i += NTHREADS) {
        const int t = i >> 5, c8 = (i & 31) * 8, s = t & (S - 1);
        const bf16_t* zr = Z + (size_t)t * ZLD;
        const u32x4 cb = *(const u32x4*)(zr + 1280 + c8);
        float acc[8];
#pragma unroll
        for (int j = 0; j < 8; ++j) acc[j] = 0.f;
#pragma unroll
        for (int w = 0; w < 3; ++w) {
            const int back = 2 - w;
            if (s >= back) {
                const u32x4 cc = *(const u32x4*)(zr - (size_t)back * ZLD + 1536 + c8), ch = *(const u32x4*)(zr - (size_t)back * ZLD + 1792 + c8);
                const f32x4 w0 = *(const f32x4*)(W + w * 256 + c8), w1 = *(const f32x4*)(W + w * 256 + c8 + 4);
                acc[0] += w0.x * bflo(cc.x) * bflo(ch.x); acc[1] += w0.y * bfhi(cc.x) * bfhi(ch.x); acc[2] += w0.z * bflo(cc.y) * bflo(ch.y); acc[3] += w0.w * bfhi(cc.y) * bfhi(ch.y);
                acc[4] += w1.x * bflo(cc.z) * bflo(ch.z); acc[5] += w1.y * bfhi(cc.z) * bfhi(ch.z); acc[6] += w1.z * bflo(cc.w) * bflo(ch.w); acc[7] += w1.w * bfhi(cc.w) * bfhi(ch.w);
            }
        }
        u32x4 o; o.x = pk2(acc[0] * bflo(cb.x), acc[1] * bfhi(cb.x)); o.y = pk2(acc[2] * bflo(cb.y), acc[3] * bfhi(cb.y)); o.z = pk2(acc[4] * bflo(cb.z), acc[5] * bfhi(cb.z)); o.w = pk2(acc[6] * bflo(cb.w), acc[7] * bfhi(cb.w));
        *(u32x4*)(MIXp + (size_t)t * D + 512 + c8) = o;
#if MK_MIXER < 3 || defined(MK_EXP_NOSTAGE3)
        { const u32x4 zz = (u32x4){0u, 0u, 0u, 0u};
#if MK_MIXER < 2
          *(u32x4*)(MIXp + (size_t)t * D + c8) = zz; *(u32x4*)(MIXp + (size_t)t * D + 768 + c8) = zz;
#endif
          *(u32x4*)(MIXp + (size_t)t * D + 256 + c8) = zz; }
#endif
    }
}


constexpr int ML_STR = 144;
constexpr int ML_TILE = 64 * ML_STR;
constexpr int ML_GRP = 4 * ML_TILE + 2048;
__device__ __forceinline__ int unperm_p(int p) { return perm_s(p); }
__device__ __forceinline__ float logsigmoidf_(float x) { return x >= 0.f ? -log1pf(expf(-x)) : x - log1pf(expf(x)); }

__device__ __forceinline__ void ml_gates(const Args& a, int lane, int b, int h, int c, LAS float* vec, float& bc, float& gi) {
    const int t = b * S + c * 64 + lane;
    const float* G = (const float*)(a.ws + WS_GATES) + (size_t)t * 8;
#ifdef MK_EXP_CONSTGATES
    gi = 0.0f; const float lf = -0.01f; (void)G;
#else
    gi = G[h]; const float lf = logsigmoidf_(G[4 + h]);
#endif
    vec[128 + lane] = lf;
    LDS_WAIT(); asm volatile("" ::: "memory");
    float acc = 0.f;
    for (int s = 0; s < 64; ++s) { const float v = vec[128 + s]; acc += (s <= lane) ? v : 0.f; }
    bc = acc;
}

__device__ __forceinline__ float readlane_f(float v, int l) { return __int_as_float(__builtin_amdgcn_readlane(__float_as_int(v), l)); }
__device__ __forceinline__ float wave_scan_sum(float v, int lane) {
#define SCAN_STEP(CTRL) v += __int_as_float(__builtin_amdgcn_update_dpp(0, __float_as_int(v), CTRL, 0xf, 0xf, false))
    SCAN_STEP(0x111); SCAN_STEP(0x112); SCAN_STEP(0x114); SCAN_STEP(0x118);
#undef SCAN_STEP
    const float t0 = readlane_f(v, 15), t1 = readlane_f(v, 31), t2 = readlane_f(v, 47);
    const int row = lane >> 4;
    return v + (row >= 1 ? t0 : 0.f) + (row >= 2 ? t1 : 0.f) + (row >= 3 ? t2 : 0.f);
}
__device__ __forceinline__ float wave_scan_max(float v, int lane) {
    const int ninf = __float_as_int(-INFINITY);
#define SCAN_STEP(CTRL) v = fmaxf(v, __int_as_float(__builtin_amdgcn_update_dpp(ninf, __float_as_int(v), CTRL, 0xf, 0xf, false)))
    SCAN_STEP(0x111); SCAN_STEP(0x112); SCAN_STEP(0x114); SCAN_STEP(0x118);
#undef SCAN_STEP
    const float t0 = readlane_f(v, 15), t1 = readlane_f(v, 31), t2 = readlane_f(v, 47);
    const int row = lane >> 4;
    float r = v; if (row >= 1) r = fmaxf(r, t0); if (row >= 2) r = fmaxf(r, t1); if (row >= 3) r = fmaxf(r, t2);
    return r;
}
__device__ __forceinline__ void st_wt_f32(float* p, float v) { __hip_atomic_store((unsigned*)p, __float_as_uint(v), __ATOMIC_RELAXED, __HIP_MEMORY_SCOPE_AGENT); }

__device__ __forceinline__ void mlstm_stage1(const Args& a, const Frame& F0, int layer) {
    const Frame F = phase_frame(F0);
    const int grp = F.wave >> 2, w4 = F.wave & 3, gt = w4 * 64 + F.lane, lane = F.lane, r32 = lane & 31, hh = lane >> 5;
    LAS unsigned char* gl = F.lds + grp * ML_GRP;
    LAS unsigned char* Kt = gl, * Vt = gl + ML_TILE; LAS float* vec = (LAS float*)(gl + 4 * ML_TILE);
    float* CLOC = (float*)(a.ws + WS_CLOC); float* NLOC = (float*)(a.ws + WS_NLOC); float* STAT = (float*)(a.ws + WS_STAT);
    float* GV = (float*)(a.ws + WS_GV);
    u32x4 kvr[2][2], vvr[2][2]; float gir[2] = {0.f, 0.f}, gfr[2] = {0.f, 0.f};
#pragma unroll
    for (int ps = 0; ps < 2; ++ps) {
        const int u = (F.bid + 256 * ps) * 2 + grp, c = u & 31, bh = u >> 5, b = bh >> 2, h = bh & 3;
        const bf16_t* KT = (const bf16_t*)(a.ws + WS_MKT) + (size_t)bh * 64 * S + c * 64;
        const bf16_t* VT = (const bf16_t*)(a.ws + WS_MVT) + (size_t)bh * 64 * S + c * 64;
#pragma unroll
        for (int i = 0; i < 2; ++i) { const int p = gt + 256 * i, row = p >> 3, pc = p & 7; kvr[ps][i] = *(const u32x4*)(KT + (size_t)row * S + pc * 8); vvr[ps][i] = *(const u32x4*)(VT + (size_t)row * S + pc * 8); }
        if (w4 == 0) { const float* G = (const float*)(a.ws + WS_GATES) + (size_t)(b * S + c * 64 + lane) * 8; gir[ps] = G[h]; gfr[ps] = G[4 + h]; }
    }
#pragma unroll
    for (int ps = 0; ps < 2; ++ps) {
        const int u = (F.bid + 256 * ps) * 2 + grp;
        __syncthreads();
        if (w4 == 0) {
            const float gi = gir[ps], lf = logsigmoidf_(gfr[ps]);
            const float bc = wave_scan_sum(lf, lane), igmb = gi - bc;
            const float gtot = readlane_f(bc, 63);
            const float we = gtot - bc + gi; const float ml = wave_max(we);
            vec[192 + lane] = __expf(we - ml);
            const float pm = wave_scan_max(igmb, lane);
            st_wt_f32(GV + (size_t)u * 192 + lane, bc); st_wt_f32(GV + (size_t)u * 192 + 64 + lane, igmb); st_wt_f32(GV + (size_t)u * 192 + 128 + lane, pm);
            if (lane == 0) { st_wt_f32(STAT + u * 4, gtot); st_wt_f32(STAT + u * 4 + 1, ml); }
        }
        __syncthreads();
#pragma unroll
        for (int i = 0; i < 2; ++i) {
            const int p = gt + 256 * i, row = p >> 3, pc = p & 7;
            const u32x4 kv = kvr[ps][i], vv = vvr[ps][i];
            float ae[8];
#pragma unroll
            for (int j = 0; j < 8; ++j) ae[j] = vec[192 + unperm_p(pc * 8 + j)];
            u32x4 ko; ko.x = pk2(bflo(kv.x) * ae[0], bfhi(kv.x) * ae[1]); ko.y = pk2(bflo(kv.y) * ae[2], bfhi(kv.y) * ae[3]); ko.z = pk2(bflo(kv.z) * ae[4], bfhi(kv.z) * ae[5]); ko.w = pk2(bflo(kv.w) * ae[6], bfhi(kv.w) * ae[7]);
            *(LAS u32x4*)(Kt + row * ML_STR + pc * 16) = ko; *(LAS u32x4*)(Vt + row * ML_STR + pc * 16) = vv;
        }
        __syncthreads();
        if (w4 == 1) {
            float sum = 0.f;
#pragma unroll
            for (int pc = 0; pc < 8; ++pc) { const u32x4 kv = *(const LAS u32x4*)(Kt + lane * ML_STR + pc * 16);
                sum += (bflo(kv.x) + bfhi(kv.x)) + (bflo(kv.y) + bfhi(kv.y)) + (bflo(kv.z) + bfhi(kv.z)) + (bflo(kv.w) + bfhi(kv.w)); }
            st_wt_f32(NLOC + u * 64 + lane, sum);
        }
        const int eb = w4 >> 1, db = w4 & 1;
        f32x16 acc;
#pragma unroll
        for (int i = 0; i < 16; ++i) acc[i] = 0.f;
#pragma unroll
        for (int ks = 0; ks < 4; ++ks) {
            const bf16x8 af = *(const LAS bf16x8*)(Vt + (eb * 32 + r32) * ML_STR + ks * 32 + hh * 16);
            const bf16x8 bfg = *(const LAS bf16x8*)(Kt + (db * 32 + r32) * ML_STR + ks * 32 + hh * 16);
            acc = __builtin_amdgcn_mfma_f32_32x32x16_bf16(af, bfg, acc, 0, 0, 0);
        }
#pragma unroll
        for (int r = 0; r < 16; ++r) st_wt_f32(CLOC + (size_t)u * 4096 + (eb * 32 + crow(r, hh)) * 64 + db * 32 + r32, acc[r]);
    }
    asm volatile("s_waitcnt vmcnt(0)" ::: "memory");
    if (lane == 0) { __hip_atomic_fetch_add(F.ctl + CW_ML + 64 * (32 * layer + (F.bid >> 4)), 1u, __ATOMIC_RELAXED, __HIP_MEMORY_SCOPE_AGENT);
                     __hip_atomic_fetch_add(F.ctl + CW_ML + 64 * (32 * layer + 16 + (F.bid >> 4)), 1u, __ATOMIC_RELAXED, __HIP_MEMORY_SCOPE_AGENT); }
}
__device__ __forceinline__ void mlstm_scan_wait(const Frame& F, int layer, int bh) {
    if (F.tid == 0) { unsigned spins = 0;
        while (__hip_atomic_load(F.ctl + CW_ML + 64 * (32 * layer + bh), __ATOMIC_RELAXED, __HIP_MEMORY_SCOPE_AGENT) < 128u) { __builtin_amdgcn_s_sleep(2); if (++spins > (1u << 24)) break; }
        __builtin_amdgcn_fence(__ATOMIC_ACQUIRE, "agent"); VM_WAIT(); }
    __syncthreads();
}

__device__ __forceinline__ void mlstm_scan_unit(const Args& a, const Frame& F0, int su) {
    const Frame F = phase_frame(F0);
    const int bh = su >> 3, part = su & 7, idx = part * 512 + F.tid;
    const float* CLOC = (const float*)(a.ws + WS_CLOC); const float* NLOC = (const float*)(a.ws + WS_NLOC); const float* STAT = (const float*)(a.ws + WS_STAT);
    bf16_t* CPREV = (bf16_t*)(a.ws + WS_CPREV); float* NPREV = (float*)(a.ws + WS_NPREV); float* STATW = (float*)(a.ws + WS_STAT);
    float Cst = 0.f, nst = 0.f, mst = 0.f;
    const bool do_n = (part == 0) && (F.tid < 64);
#pragma unroll
    for (int half = 0; half < 2; ++half) {
        float g[16], ml[16], cl[16], nl[16];
#pragma unroll
        for (int c = 0; c < 16; ++c) { const int u = bh * 32 + half * 16 + c;
            g[c] = ld_coherent(STAT + u * 4); ml[c] = ld_coherent(STAT + u * 4 + 1);
            cl[c] = CLOC[(size_t)u * 4096 + idx]; nl[c] = do_n ? NLOC[u * 64 + F.tid] : 0.f; }
#pragma unroll
        for (int c = 0; c < 16; ++c) { const int u = bh * 32 + half * 16 + c;
            CPREV[(size_t)u * 4096 + idx] = (bf16_t)(pk2(Cst, 0.f) & 0xffffu);
            if (do_n) NPREV[u * 64 + F.tid] = nst;
            if (part == 0 && F.tid == 0) STATW[u * 4 + 2] = mst;
            const float mnew = fmaxf(g[c] + mst, ml[c]), aa = __expf(g[c] + mst - mnew), bb = __expf(ml[c] - mnew);
            Cst = aa * Cst + bb * cl[c]; nst = aa * nst + bb * nl[c]; mst = mnew; }
    }
}

__device__ __forceinline__ void mlstm_stage3_item(const Args& a, const Frame& F0, int item) {
    const Frame F = phase_frame(F0);
    const int grp = F.wave >> 2, w4 = F.wave & 3, gt = w4 * 64 + F.lane, lane = F.lane, r32 = lane & 31, hh = lane >> 5;
    LAS unsigned char* gl = F.lds + grp * ML_GRP;
    LAS unsigned char* Qs = gl, * Ks = gl + ML_TILE, * Vt = gl + 2 * ML_TILE, * Cs = gl + 3 * ML_TILE; LAS float* vec = (LAS float*)(gl + 4 * ML_TILE);
    const float* STAT = (const float*)(a.ws + WS_STAT); const float* GV = (const float*)(a.ws + WS_GV); const float* NPV = (const float*)(a.ws + WS_NPREV);
    u32x4 tq[2], tk[2], tv[2], tc[2]; float g_bc = 0.f, g_ig = 0.f, g_pm = 0.f, g_mp = 0.f, g_np = 0.f;
#define ST3_LOAD(pp) do { const int u_ = (item * 4 + (pp)) * 2 + grp, c_ = u_ & 31, bh_ = u_ >> 5, b_ = bh_ >> 2, h_ = bh_ & 3; \
        const bf16_t* Z_ = (const bf16_t*)(a.ws + WS_Z) + ((size_t)b_ * S + c_ * 64) * ZLD; const bf16_t* VT_ = (const bf16_t*)(a.ws + WS_MVT) + (size_t)bh_ * 64 * S + c_ * 64; \
        const bf16_t* CP_ = (const bf16_t*)(a.ws + WS_CPREV) + (size_t)u_ * 4096; \
        _Pragma("unroll") for (int i_ = 0; i_ < 2; ++i_) { const int p_ = gt + 256 * i_, row_ = p_ >> 3, pc_ = p_ & 7; \
            tq[i_] = __builtin_nontemporal_load((const u32x4*)(Z_ + (size_t)row_ * ZLD + 512 + h_ * 64 + pc_ * 8)); tk[i_] = __builtin_nontemporal_load((const u32x4*)(Z_ + (size_t)row_ * ZLD + 768 + h_ * 64 + pc_ * 8)); \
            tv[i_] = __builtin_nontemporal_load((const u32x4*)(VT_ + (size_t)row_ * S + pc_ * 8)); tc[i_] = __builtin_nontemporal_load((const u32x4*)(CP_ + row_ * 64 + pc_ * 8)); } \
        if (w4 == 0) { g_bc = GV[(size_t)u_ * 192 + lane]; g_ig = GV[(size_t)u_ * 192 + 64 + lane]; g_pm = GV[(size_t)u_ * 192 + 128 + lane]; g_mp = ld_coherent(STAT + u_ * 4 + 2); g_np = NPV[u_ * 64 + lane]; } } while (0)
    ST3_LOAD(0);
    for (int pp = 0; pp < 4; ++pp) {
        const int u = (item * 4 + pp) * 2 + grp, c = u & 31, bh = u >> 5, b = bh >> 2, h = bh & 3;
        __syncthreads();
#pragma unroll
        for (int i = 0; i < 2; ++i) { const int p = gt + 256 * i, row = p >> 3, pc = p & 7;
            *(LAS u32x4*)(Qs + row * ML_STR + pc * 16) = tq[i]; *(LAS u32x4*)(Ks + row * ML_STR + pc * 16) = tk[i];
            *(LAS u32x4*)(Vt + row * ML_STR + pc * 16) = tv[i]; *(LAS u32x4*)(Cs + row * ML_STR + pc * 16) = tc[i]; }
        if (w4 == 0) { const float il = g_bc + g_mp, mj = fmaxf(il, g_bc + g_pm);
            vec[lane] = g_bc; vec[64 + lane] = g_ig; vec[192 + lane] = mj; vec[256 + lane] = __expf(il - mj); vec[320 + lane] = g_np; }
        if (pp + 1 < 4) ST3_LOAD(pp + 1);
        __syncthreads();
        const int jb = w4 & 1, eb = w4 >> 1, j = jb * 32 + r32;
        const float mj = vec[192 + j], ainter = vec[256 + j], bj = vec[j] - mj;
        const size_t trow = (size_t)b * S + c * 64 + j;
        const bf16_t* orow = (const bf16_t*)(a.ws + WS_Z) + trow * ZLD + 1024 + h * 64 + eb * 32;
        u32x2 ovr[4];
#pragma unroll
        for (int g = 0; g < 4; ++g) ovr[g] = *(const u32x2*)(orow + 8 * g + 4 * hh);
        f32x16 p0, p1, X;
#pragma unroll
        for (int i = 0; i < 16; ++i) { p0[i] = 0.f; p1[i] = 0.f; X[i] = 0.f; }
        bf16x8 qf[4];
#pragma unroll
        for (int ks = 0; ks < 4; ++ks) qf[ks] = *(const LAS bf16x8*)(Qs + j * ML_STR + ks * 32 + hh * 16);
#pragma unroll
        for (int ks = 0; ks < 4; ++ks) {
            const bf16x8 k0 = *(const LAS bf16x8*)(Ks + r32 * ML_STR + ks * 32 + hh * 16), k1 = *(const LAS bf16x8*)(Ks + (32 + r32) * ML_STR + ks * 32 + hh * 16);
            const bf16x8 cf = *(const LAS bf16x8*)(Cs + (eb * 32 + r32) * ML_STR + ks * 32 + hh * 16);
            p0 = __builtin_amdgcn_mfma_f32_32x32x16_bf16(k0, qf[ks], p0, 0, 0, 0);
            p1 = __builtin_amdgcn_mfma_f32_32x32x16_bf16(k1, qf[ks], p1, 0, 0, 0);
            X = __builtin_amdgcn_mfma_f32_32x32x16_bf16(cf, qf[ks], X, 0, 0, 0);
        }
        float rs = 0.f;
#pragma unroll
        for (int r = 0; r < 16; ++r) {
            const int s0 = crow(r, hh), s1 = 32 + s0;
            const float w0 = (s0 <= j) ? __expf(bj + vec[64 + s0]) * 0.125f : 0.f, w1 = (s1 <= j) ? __expf(bj + vec[64 + s1]) * 0.125f : 0.f;
            p0[r] *= w0; p1[r] *= w1; rs += p0[r] + p1[r];
        }
        rs = xor32_sum(rs);
        float qn = 0.f;
#pragma unroll
        for (int pc = 0; pc < 4; ++pc) { const u32x4 qv = *(const LAS u32x4*)(Qs + j * ML_STR + (hh * 4 + pc) * 16); const LAS float* nv = vec + 320 + hh * 32 + pc * 8;
            qn += bflo(qv.x) * nv[0] + bfhi(qv.x) * nv[1] + bflo(qv.y) * nv[2] + bfhi(qv.y) * nv[3] + bflo(qv.z) * nv[4] + bfhi(qv.z) * nv[5] + bflo(qv.w) * nv[6] + bfhi(qv.w) * nv[7]; }
        qn = xor32_sum(qn);
        const float den = ainter * qn * 0.125f + rs;
        const float dinv = __builtin_amdgcn_rcpf(fmaxf(fabsf(den), __expf(-mj)));
        f32x16 Y;
#pragma unroll
        for (int i = 0; i < 16; ++i) Y[i] = 0.f;
#pragma unroll
        for (int kbk = 0; kbk < 2; ++kbk)
#pragma unroll
            for (int s2 = 0; s2 < 2; ++s2) {
                u32x4 pw;
                if (kbk == 0) { pw.x = pk2(p0[8 * s2], p0[8 * s2 + 1]); pw.y = pk2(p0[8 * s2 + 2], p0[8 * s2 + 3]); pw.z = pk2(p0[8 * s2 + 4], p0[8 * s2 + 5]); pw.w = pk2(p0[8 * s2 + 6], p0[8 * s2 + 7]); }
                else { pw.x = pk2(p1[8 * s2], p1[8 * s2 + 1]); pw.y = pk2(p1[8 * s2 + 2], p1[8 * s2 + 3]); pw.z = pk2(p1[8 * s2 + 4], p1[8 * s2 + 5]); pw.w = pk2(p1[8 * s2 + 6], p1[8 * s2 + 7]); }
                const bf16x8 af = *(const LAS bf16x8*)(Vt + (eb * 32 + r32) * ML_STR + (kbk * 32 + s2 * 16) * 2 + hh * 16);
                Y = __builtin_amdgcn_mfma_f32_32x32x16_bf16(af, __builtin_bit_cast(bf16x8, pw), Y, 0, 0, 0);
            }
        bf16_t* yrow = (bf16_t*)(a.ws + WS_MIX) + trow * D + 256 + h * 64 + eb * 32;
        const float xs = ainter * 0.125f;
        u32x2 wv[4];
#pragma unroll
        for (int g = 0; g < 4; ++g) {
            const u32x2 ov = ovr[g];
            const float o0 = sigmoidf_(bflo(ov.x)), o1 = sigmoidf_(bfhi(ov.x)), o2 = sigmoidf_(bflo(ov.y)), o3 = sigmoidf_(bfhi(ov.y));
            wv[g].x = pk2((xs * X[4 * g] + Y[4 * g]) * dinv * o0, (xs * X[4 * g + 1] + Y[4 * g + 1]) * dinv * o1);
            wv[g].y = pk2((xs * X[4 * g + 2] + Y[4 * g + 2]) * dinv * o2, (xs * X[4 * g + 3] + Y[4 * g + 3]) * dinv * o3);
        }
        *(u32x4*)(yrow + 8 * hh) = pair_cols32(wv[0], wv[1]); *(u32x4*)(yrow + 8 * (2 + hh)) = pair_cols32(wv[2], wv[3]);
    }
#undef ST3_LOAD
}

struct P6Pre { f32x4 pg[4], pb[4], psh[4], psc[4], pg1[4]; u32x2 rxa[4], rxb[4]; };
__device__ __forceinline__ void p6_prefetch(const Args& args, const Frame& F0, int l, P6Pre& P) {
    const Frame F = phase_frame(F0);
    const int m0 = F.gw * 8, b = m0 >> 11; const bf16_t* XB = (const bf16_t*)args.out;
#pragma unroll
    for (int j = 0; j < 4; ++j) { const int c = colj(F.lane, j);
        P.pg[j] = *(const f32x4*)(args.in[I_LN1G] + l * D + c); P.pb[j] = *(const f32x4*)(args.in[I_LN1B] + l * D + c);
        P.psh[j] = mod4(args, l, b, 3072 + c); P.psc[j] = mod4(args, l, b, 4096 + c) + 1.0f; P.pg1[j] = mod4(args, l, b, 2048 + c); }
#pragma unroll
    for (int jp = 0; jp < 2; ++jp) { const int c = colj(F.lane, 2 * jp);
        ld_bf16x8_nt(XB + (size_t)m0 * D + c, P.rxa[2 * jp], P.rxa[2 * jp + 1]); ld_bf16x8_nt(XB + (size_t)(m0 + 1) * D + c, P.rxb[2 * jp], P.rxb[2 * jp + 1]); }
    const float* WR = args.in[I_WR]; LAS float* wl = (LAS float*)F.lds;
    __syncthreads();
    for (int i = F.tid; i < 1024 * 4; i += NTHREADS) { const int c = i >> 2, q = i & 3; *(LAS f32x4*)(wl + c * 16 + (c >> 3) * 4 + q * 4) = *(const f32x4*)(WR + (size_t)c * 16 + q * 4); }
}
__device__ __forceinline__ void phase_ln1_router(const Args& args, const Frame& F0, int l, const float* xin_skel, bool do_lists, const P6Pre& P) {
    const Frame F = phase_frame(F0);
    bf16_t* PRE = (bf16_t*)(args.ws + WS_PRE); bf16_t* U = (bf16_t*)(args.ws + WS_U);
    int* LIST = (int*)(args.ws + WS_LIST); float* ROUTE = (float*)(args.ws + WS_ROUTE);
    const float* WR = args.in[I_WR]; const float* BR = args.in[I_BR];
    LAS float* wl = (LAS float*)F.lds;
    LAS unsigned* cntL = (LAS unsigned*)(F.lds + 73728);
    LAS unsigned* recs = cntL + 32;
    if (F.tid < 32) cntL[F.tid] = 0u;
    __syncthreads();
    const int m0 = F.gw * 8, b = m0 >> 11;
    f32x4 pg[4], pb[4], psh[4], psc[4], pg1[4];
#pragma unroll
    for (int j = 0; j < 4; ++j) { pg[j] = P.pg[j]; pb[j] = P.pb[j]; psh[j] = P.psh[j]; psc[j] = P.psc[j]; pg1[j] = P.pg1[j]; }
    (void)b;
    const bf16_t* XB = (const bf16_t*)args.out;
    u32x2 nxa[4], nxb[4], rxa[4], rxb[4];
#pragma unroll
    for (int jp = 0; jp < 2; ++jp) { const int c = colj(F.lane, 2 * jp);
        ld_bf16x8_nt(PRE + (size_t)m0 * D + c, nxa[2 * jp], nxa[2 * jp + 1]); ld_bf16x8_nt(PRE + (size_t)(m0 + 1) * D + c, nxb[2 * jp], nxb[2 * jp + 1]);
        rxa[2 * jp] = P.rxa[2 * jp]; rxa[2 * jp + 1] = P.rxa[2 * jp + 1]; rxb[2 * jp] = P.rxb[2 * jp]; rxb[2 * jp + 1] = P.rxb[2 * jp + 1]; }
    for (int it = 0; it < 8; it += 2) {
        const int m = m0 + it;
        f32x4 va[4], vb[4];
#pragma unroll
        for (int j = 0; j < 4; ++j) { va[j] = (f32x4){bflo(nxa[j].x), bfhi(nxa[j].x), bflo(nxa[j].y), bfhi(nxa[j].y)}; vb[j] = (f32x4){bflo(nxb[j].x), bfhi(nxb[j].x), bflo(nxb[j].y), bfhi(nxb[j].y)};
            const f32x4 xa = (f32x4){bflo(rxa[j].x), bfhi(rxa[j].x), bflo(rxa[j].y), bfhi(rxa[j].y)}, xb = (f32x4){bflo(rxb[j].x), bfhi(rxb[j].x), bflo(rxb[j].y), bfhi(rxb[j].y)};
            va[j] = xa * DN_ALPHA + pg1[j] * va[j]; vb[j] = xb * DN_ALPHA + pg1[j] * vb[j]; }
        if (it < 6) {
#pragma unroll
            for (int jp = 0; jp < 2; ++jp) { const int c = colj(F.lane, 2 * jp);
                ld_bf16x8_nt(PRE + (size_t)(m + 2) * D + c, nxa[2 * jp], nxa[2 * jp + 1]); ld_bf16x8_nt(PRE + (size_t)(m + 3) * D + c, nxb[2 * jp], nxb[2 * jp + 1]);
                ld_bf16x8_nt(XB + (size_t)(m + 2) * D + c, rxa[2 * jp], rxa[2 * jp + 1]); ld_bf16x8_nt(XB + (size_t)(m + 3) * D + c, rxb[2 * jp], rxb[2 * jp + 1]); } }
        float meana, rstda, meanb, rstdb; ln_stats(va, meana, rstda); ln_stats(vb, meanb, rstdb);
#pragma unroll
        for (int j = 0; j < 4; ++j) { va[j] = (va[j] - meana) * rstda * pg[j] + pb[j]; vb[j] = (vb[j] - meanb) * rstdb * pg[j] + pb[j]; }
#pragma unroll
        for (int jp = 0; jp < 2; ++jp) { const int c = colj(F.lane, 2 * jp);
            st_bf16x8_nt(PRE + (size_t)m * D + c, va[2 * jp], va[2 * jp + 1]); st_bf16x8_nt(PRE + (size_t)(m + 1) * D + c, vb[2 * jp], vb[2 * jp + 1]); }
        ln_stats(va, meana, rstda); ln_stats(vb, meanb, rstdb);
        float lga[16], lgb[16];
#pragma unroll
        for (int e = 0; e < 16; ++e) { lga[e] = 0.f; lgb[e] = 0.f; }
        f32x4 uap = F4ZERO, ubp = F4ZERO;
#pragma unroll
        for (int j = 0; j < 4; ++j) {
            const int c = colj(F.lane, j);
            const f32x4 ua = (va[j] - meana) * rstda * psc[j] + psh[j], ub = (vb[j] - meanb) * rstdb * psc[j] + psh[j];
            if (j & 1) { st_bf16x8(U + (size_t)m * D + c - 4, uap, ua); st_bf16x8(U + (size_t)(m + 1) * D + c - 4, ubp, ub); } else { uap = ua; ubp = ub; }
#pragma unroll
            for (int i = 0; i < 4; ++i) { const LAS f32x4* w = (const LAS f32x4*)(wl + (c + i) * 16 + (c >> 3) * 4);
#pragma unroll
                for (int q = 0; q < 4; ++q) { const f32x4 wv = w[q];
                    lga[4 * q] += ua[i] * wv.x; lga[4 * q + 1] += ua[i] * wv.y; lga[4 * q + 2] += ua[i] * wv.z; lga[4 * q + 3] += ua[i] * wv.w;
                    lgb[4 * q] += ub[i] * wv.x; lgb[4 * q + 1] += ub[i] * wv.y; lgb[4 * q + 2] += ub[i] * wv.z; lgb[4 * q + 3] += ub[i] * wv.w; } }
        }
#pragma unroll
        for (int e = 0; e < 16; ++e) { lga[e] = wave_sum(lga[e]); lgb[e] = wave_sum(lgb[e]); }
        int e0a, e1a, e0b, e1b; float w0a, w1a, w0b, w1b; route_select(lga, BR, e0a, e1a, w0a, w1a); route_select(lgb, BR, e0b, e1b, w0b, w1b);
        if (F.lane == 0 && do_lists) {
            ROUTE[m * 2] = w0a; ROUTE[m * 2 + 1] = w1a; ROUTE[m * 2 + 2] = w0b; ROUTE[m * 2 + 3] = w1b;
            const unsigned r0 = __hip_atomic_fetch_add(cntL + e0a, 1u, __ATOMIC_RELAXED, __HIP_MEMORY_SCOPE_WORKGROUP);
            const unsigned r1 = __hip_atomic_fetch_add(cntL + e1a, 1u, __ATOMIC_RELAXED, __HIP_MEMORY_SCOPE_WORKGROUP);
            const unsigned r2 = __hip_atomic_fetch_add(cntL + e0b, 1u, __ATOMIC_RELAXED, __HIP_MEMORY_SCOPE_WORKGROUP);
            const unsigned r3 = __hip_atomic_fetch_add(cntL + e1b, 1u, __ATOMIC_RELAXED, __HIP_MEMORY_SCOPE_WORKGROUP);
            recs[(F.wave * 8 + it) * 2] = ((unsigned)e0a << 24) | r0; recs[(F.wave * 8 + it) * 2 + 1] = ((unsigned)e1a << 24) | r1;
            recs[(F.wave * 8 + it + 1) * 2] = ((unsigned)e0b << 24) | r2; recs[(F.wave * 8 + it + 1) * 2 + 1] = ((unsigned)e1b << 24) | r3;
        }
    }
    if (do_lists) {
        __syncthreads();
        if (F.tid < 16) cntL[16 + F.tid] = atomicAdd(F.ctl + CW_CNT + 64 * (16 * l + F.tid), cntL[F.tid]);
        __syncthreads();
        if (F.tid < 64) { const int w = F.tid >> 3, i = F.tid & 7; const int m = (F.bid * NWAVES + w) * 8 + i;
            if (m < T) {
#pragma unroll
                for (int k = 0; k < 2; ++k) { const unsigned rc = recs[F.tid * 2 + k]; const int e = (int)(rc >> 24); LIST[e * T + cntL[16 + e] + (rc & 0xffffffu)] = m * 2 + k; } } }
    }
}
__device__ __forceinline__ void phase_ln2_final(const Args& args, const Frame& F0, int l, bool with_moe) {
    const Frame F = phase_frame(F0);
    const bf16_t* X1 = (const bf16_t*)(args.ws + WS_PRE); const bf16_t* YB = (const bf16_t*)(args.ws + WS_YB); bf16_t* U = (bf16_t*)(args.ws + WS_U);
    const int m0 = F.gw * 8, b = m0 >> 11;
    f32x4 pg2[4], pg[4], pb[4], psh[4], psc[4];
#pragma unroll
    for (int j = 0; j < 4; ++j) { const int c = colj(F.lane, j);
        pg2[j] = mod4(args, l, b, 5120 + c); pg[j] = *(const f32x4*)(args.in[I_LN2G] + l * D + c); pb[j] = *(const f32x4*)(args.in[I_LN2B] + l * D + c);
        if (l + 1 < DEPTH) { psh[j] = mod4(args, l + 1, b, c); psc[j] = mod4(args, l + 1, b, 1024 + c) + 1.0f; } else { psh[j] = F4ZERO; psc[j] = F4ZERO; } }
    u32x2 nx[4], ny0[4], ny1[4];
#define P9_LOAD(mm) do { _Pragma("unroll") for (int jp = 0; jp < 2; ++jp) { const int c = colj(F.lane, 2 * jp); ld_bf16x8_nt(X1 + (size_t)(mm) * D + c, nx[2 * jp], nx[2 * jp + 1]); \
        ld_bf16x8_nt(YB + (size_t)(2 * (mm)) * D + c, ny0[2 * jp], ny0[2 * jp + 1]); ld_bf16x8_nt(YB + (size_t)(2 * (mm) + 1) * D + c, ny1[2 * jp], ny1[2 * jp + 1]); } } while (0)
    P9_LOAD(m0);
    for (int it = 0; it < 8; ++it) {
        const int m = m0 + it;
        f32x4 v[4];
#pragma unroll
        for (int j = 0; j < 4; ++j) {
            const f32x4 x1 = (f32x4){bflo(nx[j].x), bfhi(nx[j].x), bflo(nx[j].y), bfhi(nx[j].y)};
            const f32x4 y = (f32x4){bflo(ny0[j].x) + bflo(ny1[j].x), bfhi(ny0[j].x) + bfhi(ny1[j].x), bflo(ny0[j].y) + bflo(ny1[j].y), bfhi(ny0[j].y) + bfhi(ny1[j].y)};
            v[j] = x1 * DN_ALPHA + (with_moe ? pg2[j] * y : F4ZERO);
        }
        if (it < 7) P9_LOAD(m + 1);
        float mean, rstd; ln_stats(v, mean, rstd);
#pragma unroll
        for (int j = 0; j < 4; ++j) {
            const int c = colj(F.lane, j);
            v[j] = (v[j] - mean) * rstd * pg[j] + pb[j];
            if (MK_STAMP >= 0 && l + 1 == DEPTH && m == 0 && j == 0 && F.lane == 0) { const unsigned long long d_ = __hip_atomic_load((unsigned long long*)(F.ctl + CW_STAMP) + 1, __ATOMIC_RELAXED, __HIP_MEMORY_SCOPE_AGENT); v[j].x = (float)d_ * 0.01f; }
            if (l + 1 == DEPTH) __builtin_nontemporal_store(v[j], (f32x4*)(args.out + (size_t)m * D + c));
        }
        if (l + 1 < DEPTH) { st_bf16x8_nt((bf16_t*)args.out + (size_t)m * D + colj(F.lane, 0), v[0], v[1]); st_bf16x8_nt((bf16_t*)args.out + (size_t)m * D + colj(F.lane, 2), v[2], v[3]); }
        if (l + 1 < DEPTH) {
            ln_stats(v, mean, rstd);
#pragma unroll
            for (int jp = 0; jp < 2; ++jp) st_bf16x8(U + (size_t)m * D + colj(F.lane, 2 * jp), (v[2 * jp] - mean) * rstd * psc[2 * jp] + psh[2 * jp], (v[2 * jp + 1] - mean) * rstd * psc[2 * jp + 1] + psh[2 * jp + 1]);
        }
    }
#undef P9_LOAD
}

#define GRID_BAR() xcd_barrier(bar)
#define STAMP_T0(k) do { if (MK_STAMP == (k) && F.bid == 0 && F.wave == 0 && lane_id() == 0) { unsigned long long* st_ = (unsigned long long*)(F.ctl + CW_STAMP); st_[0] = __builtin_amdgcn_s_memrealtime(); } } while (0)
#define STAMP_T1(k) do { if (MK_STAMP == (k) && F.bid == 0 && F.wave == 0 && lane_id() == 0) { unsigned long long* st_ = (unsigned long long*)(F.ctl + CW_STAMP); st_[1] = __builtin_amdgcn_s_memrealtime() - st_[0]; } } while (0)
#define STAMP(k) do { STAMP_T1((k) - 1); STAMP_T0(k); } while (0)
template <int l>
__device__ __forceinline__ void layer_body(const Frame& F, const XcdBarrier& bar, volatile LAS unsigned* MISC) {
        STAMP_T0(l * 10 + 1);
#if MK_MIXER
        REPS(1) {
        {
            const Args args = load_args();
            pg8::Gemm g{(const bf16_t*)(args.ws + WS_U), (const bf16_t*)(args.ws + WS_BTIN), D, D, nullptr};
            pg8::StaticOrder So; const Frame Fp = phase_frame(F); So.init(T, NIN, D, D, Fp.G, Fp.bid); EpiIn E{args.ws, args.in[I_BI], args.in[I_BF], l};
            pg8::gemm_phase<EpiIn, pg8::StaticOrder, false>(F.lds, Fp.wave, g, So, E);
        }
        GRID_BAR();
        }
        STAMP(l * 10 + 2);
        REPS(2) {
#if MK_MIXER >= 3
        { const Args args = load_args(); mlstm_stage1(args, F, l); }
#endif
        {
            const Args args = load_args();
            __syncthreads();
            pg8::Gemm g{(const bf16_t*)(args.ws + WS_Z), (const bf16_t*)(args.ws + WS_BTUP), ZLD, 256, nullptr};
            pg8::StaticOrder So; const Frame Fp = phase_frame(F); So.init(T, 1024, ZLD, 256, Fp.G, Fp.bid); So.kpn = 2; So.koff = 128; EpiUp E{args.ws, l, F.lds};
            pg8::gemm_phase<EpiUp, pg8::StaticOrder, false>(F.lds, Fp.wave, g, So, E);
        }
#if MK_MIXER >= 3
        { const Args args = load_args(); const Frame Fp = phase_frame(F);
          for (int su = Fp.bid; su < 256; su += Fp.G) { mlstm_scan_wait(Fp, l, su >> 3); mlstm_scan_unit(args, Fp, su); } }
#endif
        GRID_BAR();
        }
        STAMP(l * 10 + 3);
        REPS(3) {
        {
            const Args args = load_args(); const Frame Fp = phase_frame(F);
            const int xcc = (int)(bar.x & 7u);
            bool own_live = true;
            for (;;) { const int qj = queue_next_xcd(Fp, l * 2 + rep_, xcc, 96, own_live); if (qj < 0) break;
                const int q = qj >> 16, j = qj & 0xffff;
                const bool is_ml = (j >= 32 && j < 48), is_cv = (j >= 80); const int ja = (j < 32) ? j : j - 16;
                if (rep_ && MK_PROBE_KIND) { const int kind = (is_ml || is_cv) ? 3 : ((ja & 4) ? 2 : 1); if (kind != MK_PROBE_KIND) continue; }
                if (is_ml) { const int bh = ((j - 32) >> 2) * 8 + q; mlstm_stage3_item(args, Fp, bh * 4 + ((j - 32) & 3)); }
                else if (is_cv) conv_item(args, Fp, l, (j - 80) * 8 + q);
                else { const int qb = 7 - (ja >> 3), bh = (ja & 3) * 8 + q;
                    if (ja & 4) mla_unit(args, Fp, bh, qb); else diff_unit(args, Fp, l, bh, qb); }
            }
            if (rep_ == 0) { __syncthreads(); convert_weights(args, F, l, 1); }
        }
        GRID_BAR();
        }
        STAMP(l * 10 + 4);
        STAMP(l * 10 + 5);
        P6Pre p6;
        REPS(5) {
        {
            const Args args = load_args(); const bf16_t* xin = (const bf16_t*)args.out;
            pg8::Gemm g{(const bf16_t*)(args.ws + WS_MIX), (const bf16_t*)(args.ws + WS_BTOUT), D, D, nullptr};
            pg8::StaticOrder So; const Frame Fp = phase_frame(F); So.init(T, D, D, D, Fp.G, Fp.bid); EpiOut E{args.ws};
            pg8::gemm_phase<EpiOut, pg8::StaticOrder, false>(F.lds, Fp.wave, g, So, E);
            p6_prefetch(args, F, l, p6);
        }
        GRID_BAR();
        }
#endif
        STAMP(l * 10 + 6);
        { const Args args = load_args();
          phase_ln1_router(args, F, l, nullptr, true, p6);
          REPS(6) { if (rep_) { GRID_BAR(); phase_ln1_router(args, F, l, nullptr, false, p6); } } }
        GRID_BAR();
        STAMP(l * 10 + 7);
        REPS(7) {
        moe_tile_table(F, l);
        {
            const Args args = load_args();
            pg8::Gemm g{(const bf16_t*)(args.ws + WS_U), (const bf16_t*)(args.ws + WS_BT13), D, D, (const int*)(args.ws + WS_LIST)};
            const Frame Fp = phase_frame(F); unsigned* rdy = (unsigned*)(F.ctl + CW_MOE + 64 * 160 * (2 * l + rep_));
            MoeOrder So{MISC, 2, 1, (unsigned*)(F.ctl + CW_MQ + 64 * 8 * (4 * l + 2 * rep_)), Fp.wave, rdy, (int)(bar.x & 7u), true}; EpiMoe1 E{args.ws, rdy, F.lds};
            pg8::gemm_phase<EpiMoe1, MoeOrder, true>(F.lds, Fp.wave, g, So, E);
        }
        if (!(rep_ && MK_PROBE_KIND == 1)) {
            const Args args = load_args();
            pg8::Gemm g{(const bf16_t*)(args.ws + WS_H), (const bf16_t*)(args.ws + WS_BT2), DEXP, DEXP, nullptr};
            const Frame Fp = phase_frame(F); unsigned* rdy = (unsigned*)(F.ctl + CW_MOE + 64 * 160 * (2 * l + rep_));
            MoeOrder So{MISC, 4, 2, (unsigned*)(F.ctl + CW_MQ + 64 * 8 * (4 * l + 2 * rep_ + 1)), Fp.wave, rdy, (int)(bar.x & 7u), true}; EpiMoe2 E{args.ws, F.lds};
            pg8::gemm_phase<EpiMoe2, MoeOrder, false>(F.lds, Fp.wave, g, So, E);
        }
        GRID_BAR();
        }
        STAMP(l * 10 + 9);
        REPS(9) { const Args args = load_args(); if (rep_) { GRID_BAR(); phase_ln2_final(args, F, l, true); } }
        { const Args args = load_args();
          phase_ln2_final(args, F, l, true);
          if (l + 1 < DEPTH) { __syncthreads(); convert_weights(args, F, l + 1, 0); } }
        if (l + 1 < DEPTH) { GRID_BAR(); STAMP_T1(l * 10 + 9); }
}

__global__ void __launch_bounds__(NTHREADS, 2) mk_fwd(Args args_unused) {
    extern __shared__ __attribute__((aligned(16))) unsigned char lds_raw[];
    Frame F;
    F.lds = (LAS unsigned char*)lds_raw;
    { const Args a0 = load_args(); F.ws = a0.ws; F.ctl = (unsigned*)(a0.ws + WS_CTL); }
    F.wave = __builtin_amdgcn_readfirstlane((int)threadIdx.x >> 6); F.lane = lane_id(); F.tid = F.wave * 64 + F.lane;
    F.bid = blockIdx.x; F.G = gridDim.x; F.gw = F.bid * NWAVES + F.wave; F.NGW = F.G * NWAVES;
    volatile LAS unsigned* MISC = (volatile LAS unsigned*)(F.lds + LDS_MISC);
    for (int u = F.tid; u < (LDS_BYTES - LDS_MISC) / 4; u += NTHREADS) ((LAS unsigned*)(F.lds + LDS_MISC))[u] = 0u;
    __syncthreads();
    XcdBarrier bar = xcd_barrier_post(F.ctl + CW_BAR, MISC + 8, F.wave);
    STAMP_T0(100);

    { const Args args = load_args();
      REPS(10) { convert_weights(args, F, 0, 0); __syncthreads(); }
      REPS(11) { mod_gemv(args, F); }
    }
    GRID_BAR();
    STAMP_T1(100); STAMP_T0(101);
    REPS(12) {
        const Args args = load_args(); const Frame Fp = phase_frame(F);
        bf16_t* U = (bf16_t*)(args.ws + WS_U);
        for (int m = Fp.gw; m < T; m += Fp.NGW) {
            const float* xr = args.in[I_X] + (size_t)m * D;
            f32x4 v[4];
#pragma unroll
            for (int j = 0; j < 4; ++j) v[j] = __builtin_nontemporal_load((const f32x4*)(xr + colj(Fp.lane, j)));
            st_bf16x8_nt((bf16_t*)args.out + (size_t)m * D + colj(Fp.lane, 0), v[0], v[1]); st_bf16x8_nt((bf16_t*)args.out + (size_t)m * D + colj(Fp.lane, 2), v[2], v[3]);
            lnmod_row(args, Fp, 0, 0, v, m >> 11, U + (size_t)m * D);
        }
    }
    GRID_BAR();

    STAMP_T1(101);
    layer_body<0>(F, bar, MISC);
    layer_body<1>(F, bar, MISC);
}

extern "C" void kernel_launch(void* const* d_in, const int* in_sizes, int n_in, void* d_out, int out_size, void* d_ws, size_t ws_size, hipStream_t stream) {
    static int grid = 0;
    if (grid == 0) {
        if (n_in != 27 || out_size != T * D || ws_size < WS_END) { fprintf(stderr, "kernel_launch: unexpected problem (n_in %d out %d ws %zu)\n", n_in, out_size, ws_size); grid = -1; return; }
        int dev = 0, cus = 0, per_cu = 0;
        if (hipGetDevice(&dev) != hipSuccess || hipDeviceGetAttribute(&cus, hipDeviceAttributeMultiprocessorCount, dev) != hipSuccess) { grid = -1; return; }
        if (hipFuncSetAttribute((const void*)mk_fwd, hipFuncAttributeMaxDynamicSharedMemorySize, LDS_BYTES) != hipSuccess) { fprintf(stderr, "kernel_launch: hipFuncSetAttribute failed\n"); grid = -1; return; }
        if (hipOccupancyMaxActiveBlocksPerMultiprocessor(&per_cu, (const void*)mk_fwd, NTHREADS, LDS_BYTES) != hipSuccess || per_cu < 1)
            fprintf(stderr, "kernel_launch: occupancy query reports %d per CU\n", per_cu);
        (void)hipGetLastError();
        grid = cus;
    }
    if (grid < 0) return;
    (void)hipMemsetAsync((char*)d_ws + WS_CTL, 0, CTL_ZERO_BYTES, stream);
    Args a{};
    for (int i = 0; i < 27; ++i) a.in[i] = (const float*)d_in[i];
    a.out = (float*)d_out; a.ws = (unsigned char*)d_ws;
    hipLaunchKernelGGL(mk_fwd, dim3(grid), dim3(NTHREADS), LDS_BYTES, stream, a);
}
```
